# Optimizing an MI355X kernel written in HIP

```python
import math
import jax, jax.numpy as jnp
from jax import lax
import numpy as np

D_MODEL = 2048
BATCH = 8
SEQ = 2048
DEPTH = 1

HEAD_DIM = 128
N_HEADS = D_MODEL // HEAD_DIM
N_HEADS_SB = N_HEADS // 2
N_HEADS_DIL = N_HEADS - N_HEADS_SB
D_SB = N_HEADS_SB * HEAD_DIM
D_DIL = N_HEADS_DIL * HEAD_DIM
QKV_WIDTH = 3 * (D_SB + D_DIL)
DILATED_BRANCHES = ((128, 1), (512, 4), (2048, 16))
QUERY_BLOCK = 128
D_FF = 5504
CONV_WIDTH = 3
ROPE_THETA = 10000.0
RMS_EPS = 1e-6

kernel_name = 'hybrid_stickbreaking_dilated_convffn_layer'


def rmsnorm(x, gain):
    xf = x.astype(jnp.float32)
    y = xf * lax.rsqrt(jnp.mean(xf * xf, axis=-1, keepdims=True) + RMS_EPS)
    return (y * gain.astype(jnp.float32)).astype(x.dtype)


def head_rmsnorm(o, gain):
    H, Dh = o.shape[1], o.shape[3]
    of = o.astype(jnp.float32)
    y = of * lax.rsqrt(jnp.mean(of * of, axis=-1, keepdims=True) + RMS_EPS)
    return (y * gain.astype(jnp.float32).reshape(1, H, 1, Dh)).astype(o.dtype)


def apply_rope(x):
    S, Dh = x.shape[2], x.shape[3]
    inv_freq = ROPE_THETA ** (-jnp.arange(0, Dh, 2, dtype=jnp.float32) / Dh)
    ang = jnp.arange(S, dtype=jnp.float32)[:, None] * inv_freq[None, :]
    cos, sin = jnp.cos(ang), jnp.sin(ang)
    x1, x2 = jnp.split(x.astype(jnp.float32), 2, axis=-1)
    out = jnp.concatenate([x1 * cos - x2 * sin, x2 * cos + x1 * sin], axis=-1)
    return out.astype(x.dtype)


def to_heads(t, n_heads):
    B, S, _ = t.shape
    return t.reshape(B, S, n_heads, HEAD_DIM).transpose(0, 2, 1, 3)


def stick_breaking_attention(q, k, v):
    S, Dh = q.shape[2], q.shape[3]
    scale = Dh ** -0.5
    outs = []
    for blk in range(S // QUERY_BLOCK):
        q0 = blk * QUERY_BLOCK
        n_keys = q0 + QUERY_BLOCK
        q_blk = q[:, :, q0:n_keys]
        k_pre, v_pre = k[:, :, :n_keys], v[:, :, :n_keys]
        z = jnp.einsum('bhqd,bhkd->bhqk', q_blk, k_pre).astype(jnp.float32) * scale
        q_pos = q0 + jnp.arange(QUERY_BLOCK)
        k_pos = jnp.arange(n_keys)
        causal = k_pos[None, :] < q_pos[:, None]
        log_beta = jax.nn.log_sigmoid(z)
        log_keep = jnp.where(causal, jax.nn.log_sigmoid(-z), 0.0)
        log_remain = lax.cumsum(log_keep, axis=3, reverse=True) - log_keep
        a = jnp.where(causal, jnp.exp(log_beta + log_remain), 0.0)
        outs.append(jnp.einsum('bhqk,bhkd->bhqd', a.astype(v.dtype), v_pre))
    return jnp.concatenate(outs, axis=2)


def dilated_branch(q, k, v, window, dilation):
    B, H, S, Dh = q.shape
    n_back = window // dilation
    QB = QUERY_BLOCK
    L = S // dilation
    n_blocks = -(-L // QB)
    Lp = n_blocks * QB
    scale = Dh ** -0.5

    def to_sub(t):
        return t.reshape(B, H, L, dilation, Dh).transpose(0, 1, 3, 2, 4)

    qs = jnp.pad(to_sub(q), ((0, 0), (0, 0), (0, 0), (0, Lp - L), (0, 0)))
    pad_kv = ((0, 0), (0, 0), (0, 0), (QB, Lp - L), (0, 0))
    ks = jnp.pad(to_sub(k), pad_kv)
    vs = jnp.pad(to_sub(v), pad_kv)
    qb = qs.reshape(B, H, dilation, n_blocks, QB, Dh)

    def band(t):
        prev = t[:, :, :, :Lp].reshape(B, H, dilation, n_blocks, QB, Dh)
        cur = t[:, :, :, QB:QB + Lp].reshape(B, H, dilation, n_blocks, QB, Dh)
        return jnp.concatenate([prev, cur], axis=4)

    kb, vb = band(ks), band(vs)
    s = jnp.einsum('bhrnqd,bhrnkd->bhrnqk', qb, kb).astype(jnp.float32) * scale
    q_idx = jnp.arange(n_blocks)[:, None] * QB + jnp.arange(QB)[None, :]
    k_idx = jnp.arange(n_blocks)[:, None] * QB - QB + jnp.arange(2 * QB)[None, :]
    dist = q_idx[:, :, None] - k_idx[:, None, :]
    valid = (dist >= 0) & (dist <= n_back) & (k_idx[:, None, :] >= 0)
    s = jnp.where(valid, s, -jnp.inf)
    m = jnp.max(s, axis=-1, keepdims=True)
    p = jnp.exp(s - m)
    den = jnp.sum(p, axis=-1, keepdims=True)
    out = jnp.einsum('bhrnqk,bhrnkd->bhrnqd', p.astype(v.dtype), vb).astype(jnp.float32) / den
    lse = (m + jnp.log(den))[..., 0]
    out = out.reshape(B, H, dilation, Lp, Dh)[:, :, :, :L]
    out = out.transpose(0, 1, 3, 2, 4).reshape(B, H, S, Dh)
    lse = lse.reshape(B, H, dilation, Lp)[:, :, :, :L].transpose(0, 1, 3, 2).reshape(B, H, S)
    return out, lse


def dilated_attention(q, k, v):
    outs, lses = [], []
    for window, dilation in DILATED_BRANCHES:
        o, l = dilated_branch(q, k, v, window, dilation)
        outs.append(o)
        lses.append(l)
    w = jax.nn.softmax(jnp.stack(lses, axis=0), axis=0)
    out = jnp.sum(w[..., None] * jnp.stack(outs, axis=0), axis=0)
    return out.astype(q.dtype)


def conv_geglu_ffn(h, w_up, conv_w, conv_b, w_down):
    S = h.shape[1]
    u = jnp.einsum('bsd,df->bsf', h, w_up)
    up = jnp.pad(u, ((0, 0), (CONV_WIDTH - 1, 0), (0, 0)))
    u = sum(up[:, j:j + S] * conv_w[j] for j in range(CONV_WIDTH)) + conv_b
    gate, val = jnp.split(u, 2, axis=-1)
    y = jax.nn.gelu(gate, approximate=True) * val
    return jnp.einsum('bsf,fd->bsd', y, w_down)


def setup_inputs(seed: int = 0) -> dict:
    key = jax.random.key(seed)
    ks = jax.random.split(key, 16)
    f32 = jnp.float32

    def gain(k, n):
        return 1.0 + 0.05 * jax.random.normal(k, (DEPTH, n), f32)

    return {
        'x': jax.random.normal(ks[0], (BATCH, SEQ, D_MODEL), f32),
        'pre_mix_gain': gain(ks[1], D_MODEL),
        'post_mix_gain': gain(ks[2], D_MODEL),
        'pre_ffn_gain': gain(ks[3], D_MODEL),
        'post_ffn_gain': gain(ks[4], D_MODEL),
        'w_in': jax.random.normal(ks[5], (DEPTH, D_MODEL, QKV_WIDTH), f32) * D_MODEL ** -0.5,
        'sb_out_gain': gain(ks[6], D_SB),
        'dil_out_gain': gain(ks[7], D_DIL),
        'w_out': jax.random.normal(ks[8], (DEPTH, D_SB + D_DIL, D_MODEL), f32) * (D_SB + D_DIL) ** -0.5,
        'w_up': jax.random.normal(ks[9], (DEPTH, D_MODEL, 2 * D_FF), f32) * D_MODEL ** -0.5,
        'conv_w': jax.random.normal(ks[10], (DEPTH, CONV_WIDTH, 2 * D_FF), f32) * CONV_WIDTH ** -0.5,
        'conv_b': 0.02 * jax.random.normal(ks[11], (DEPTH, 2 * D_FF), f32),
        'w_down': jax.random.normal(ks[12], (DEPTH, D_FF, D_MODEL), f32) * D_FF ** -0.5,
    }


def reference(x, pre_mix_gain, post_mix_gain, pre_ffn_gain, post_ffn_gain, w_in,
              sb_out_gain, dil_out_gain, w_out, w_up, conv_w, conv_b, w_down):
    splits = [D_SB, 2 * D_SB, 3 * D_SB, 3 * D_SB + D_DIL, 3 * D_SB + 2 * D_DIL]
    for layer in range(DEPTH):
        h = rmsnorm(x, pre_mix_gain[layer])
        proj = jnp.einsum('bsd,de->bse', h, w_in[layer])
        q_sb, k_sb, v_sb, q_dl, k_dl, v_dl = jnp.split(proj, splits, axis=-1)
        o_sb = stick_breaking_attention(to_heads(q_sb, N_HEADS_SB), to_heads(k_sb, N_HEADS_SB),
                                        to_heads(v_sb, N_HEADS_SB))
        o_dl = dilated_attention(apply_rope(to_heads(q_dl, N_HEADS_DIL)),
                                 apply_rope(to_heads(k_dl, N_HEADS_DIL)),
                                 to_heads(v_dl, N_HEADS_DIL))
        o_sb = head_rmsnorm(o_sb, sb_out_gain[layer])
        o_dl = head_rmsnorm(o_dl, dil_out_gain[layer])
        B, _, S, _ = o_sb.shape
        mixed = jnp.concatenate([o_sb.transpose(0, 2, 1, 3).reshape(B, S, D_SB),
                                 o_dl.transpose(0, 2, 1, 3).reshape(B, S, D_DIL)], axis=-1)
        mix_out = jnp.einsum('bse,ed->bsd', mixed, w_out[layer])
        x = x + rmsnorm(mix_out, post_mix_gain[layer])
        h = rmsnorm(x, pre_ffn_gain[layer])
        f = conv_geglu_ffn(h, w_up[layer], conv_w[layer], conv_b[layer], w_down[layer])
        x = x + rmsnorm(f, post_ffn_gain[layer])
    return x
```

```cpp
#include <hip/hip_runtime.h>
#include <hip/hip_cooperative_groups.h>
#include <cstdio>
#include <cstdint>
namespace cg = cooperative_groups;
#ifndef ONE_LAUNCH
#define ONE_LAUNCH 1
#endif
namespace pg8 {
#define PG8_LAS __attribute__((address_space(3)))
typedef unsigned short bf16_t;
typedef short bf16x8 __attribute__((ext_vector_type(8)));
typedef float f32x4 __attribute__((ext_vector_type(4)));
typedef unsigned u32x4 __attribute__((ext_vector_type(4)));
constexpr int BM = 256, BK = 64, HALF = 128, HTB = HALF * BK * 2  , STAGE_BYTES = 8 * HTB, NXCD = 8, WGM = 2;

__host__ __device__ __forceinline__ int lds_byte(int r, int c) { const int st = (r >> 4) * 2 + (c >> 5), rr = r & 15, cc = c & 31, ob = rr * 64 + cc * 2; return st * 1024 + (ob ^ (((ob >> 9) & 1) << 5)); }
__host__ __device__ __forceinline__ void stage_rc(int b, int& R, int& C) { const int st = b / 1024, sb = b % 1024, swz = sb ^ (((sb >> 9) & 1) << 5); R = (st >> 1) * 16 + swz / 64; C = (st & 1) * 32 + (swz % 64) / 2; }
__host__ __device__ __forceinline__ int perm32(int rho) { const int n = rho >> 4, i = rho & 15; return 8 * (i >> 2) + 4 * n + (i & 3); }

struct Unit { int pm, pn; };
struct Gemm { const bf16_t* A; const bf16_t* Bt; int M, N, K; };

struct StaticOrder {
    int nM, nN, nwg, G, c;
    __host__ __device__ void init(int M, int N, int G_, int c_) { nM = M / BM; nN = N / BM; nwg = nM * nN; G = G_; c = c_; }
    __host__ __device__ bool next(int i, Unit& u) const {
        const long L = (long)i * G + c; if (L >= nwg) return false;
        int wgid = (int)L; { const int q = nwg / NXCD, r = nwg % NXCD, xcd = wgid % NXCD, off = wgid / NXCD; wgid = (xcd < r ? xcd * (q + 1) : r * (q + 1) + (xcd - r) * q) + off; }
        const int nig = WGM * nN, gid = wgid / nig, fm = gid * WGM, gsz = (nM - fm) < WGM ? (nM - fm) : WGM;
        u.pm = fm + ((wgid % nig) % gsz); u.pn = (wgid % nig) / gsz; return true;
    }
    __device__ __forceinline__ void a_ready(const Unit&) const {}
    __device__ __forceinline__ void done(const Unit&) const {}
};

__device__ __forceinline__ unsigned cvt_pk_bf16(float lo, float hi) { unsigned r; asm volatile("v_cvt_pk_bf16_f32 %0, %1, %2" : "=v"(r) : "v"(lo), "v"(hi)); return r; }
struct EpiBf16 {
    static constexpr bool PERM = true, AFTER_DRAIN = false;
    bf16_t* O; int ldc;
    __device__ __forceinline__ void operator()(const f32x4 (&acc)[2][2][4][2], const Unit& u, int wr, int wc, int fr, int fq) const {
        const int row0 = u.pm * BM + wr * 64 + fr; const int col0 = u.pn * BM + wc * 32 + 8 * fq;
#pragma unroll
        for (int ai = 0; ai < 2; ++ai)
#pragma unroll
            for (int m = 0; m < 4; ++m) { bf16_t* rowp = O + (size_t)(row0 + ai * HALF + m * 16) * ldc + col0;
#pragma unroll
                for (int bj = 0; bj < 2; ++bj) { const f32x4 v0 = acc[ai][bj][m][0], v1 = acc[ai][bj][m][1];
                    u32x4 w; w.x = cvt_pk_bf16(v0[0], v0[1]); w.y = cvt_pk_bf16(v0[2], v0[3]); w.z = cvt_pk_bf16(v1[0], v1[1]); w.w = cvt_pk_bf16(v1[2], v1[3]);
                    *(u32x4*)(rowp + bj * HALF) = w; } }
    }
};
struct EpiQKV {
    static constexpr bool PERM = true, AFTER_DRAIN = false;
    bf16_t* O; const float* rope; float c2;
    __device__ __forceinline__ void operator()(const f32x4 (&acc)[2][2][4][2], const Unit& u, int wr, int wc, int fr, int fq) const {
        const int row0 = u.pm * BM + wr * 64 + fr; const int col0 = u.pn * BM + wc * 32 + 8 * fq;
        const int seg = u.pn >> 2; const float sc = (seg == 0 || seg == 3) ? c2 : 1.f; const bool rot = (seg == 3 || seg == 4);
#pragma unroll
        for (int ai = 0; ai < 2; ++ai)
#pragma unroll
            for (int m = 0; m < 4; ++m) { const int row = row0 + ai * HALF + m * 16; bf16_t* rowp = O + (size_t)row * 6144 + col0; const int pos = row & 2047;
#pragma unroll
                for (int bj = 0; bj < 2; ++bj) { f32x4 v0 = acc[ai][bj][m][0], v1 = acc[ai][bj][m][1];
                    if (rot) { const int dp = ((col0 + bj * HALF) & 127) >> 1; const f32x4* tp = (const f32x4*)(rope + ((size_t)pos * 64 + dp) * 2);
                        const f32x4 t0 = tp[0], t1 = tp[1];
                        v0 = (f32x4){v0[0] * t0[0] - v0[1] * t0[1], v0[1] * t0[0] + v0[0] * t0[1], v0[2] * t0[2] - v0[3] * t0[3], v0[3] * t0[2] + v0[2] * t0[3]};
                        v1 = (f32x4){v1[0] * t1[0] - v1[1] * t1[1], v1[1] * t1[0] + v1[0] * t1[1], v1[2] * t1[2] - v1[3] * t1[3], v1[3] * t1[2] + v1[2] * t1[3]}; }
                    v0 = v0 * sc; v1 = v1 * sc;
                    u32x4 w; w.x = cvt_pk_bf16(v0[0], v0[1]); w.y = cvt_pk_bf16(v0[2], v0[3]); w.z = cvt_pk_bf16(v1[0], v1[1]); w.w = cvt_pk_bf16(v1[2], v1[3]);
                    *(u32x4*)(rowp + bj * HALF) = w; } }
    }
};

typedef unsigned u32x2 __attribute__((ext_vector_type(2)));

template <int CTRL> __device__ __forceinline__ float dppf(float x) { return __builtin_bit_cast(float, __builtin_amdgcn_update_dpp(0, __builtin_bit_cast(int, x), CTRL, 0xf, 0xf, false)); }
template <int CTRL> __device__ __forceinline__ f32x4 dpp4(f32x4 v) { return (f32x4){dppf<CTRL>(v[0]), dppf<CTRL>(v[1]), dppf<CTRL>(v[2]), dppf<CTRL>(v[3])}; }
__device__ __forceinline__ float gelu_tanh_f(float x) { const float t = x * (1.f + 0.044715f * x * x) * 2.3022081983f; return x * __builtin_amdgcn_rcpf(1.f + __builtin_amdgcn_exp2f(-t)); }
__device__ __forceinline__ f32x4 ldh(const float* p) {
    const unsigned long long a = __hip_atomic_load((const unsigned long long*)p, __ATOMIC_RELAXED, __HIP_MEMORY_SCOPE_AGENT), b = __hip_atomic_load((const unsigned long long*)p + 1, __ATOMIC_RELAXED, __HIP_MEMORY_SCOPE_AGENT);
    return (f32x4){__builtin_bit_cast(float, (unsigned)a), __builtin_bit_cast(float, (unsigned)(a >> 32)), __builtin_bit_cast(float, (unsigned)b), __builtin_bit_cast(float, (unsigned)(b >> 32))}; }
template <int CTRL> __device__ __forceinline__ float dppo(float old, float x) { return __builtin_bit_cast(float, __builtin_amdgcn_update_dpp(__builtin_bit_cast(int, old), __builtin_bit_cast(int, x), CTRL, 0xf, 0xf, false)); }
template <int CTRL> __device__ __forceinline__ f32x4 dppo4(f32x4 o, f32x4 v) { return (f32x4){dppo<CTRL>(o[0], v[0]), dppo<CTRL>(o[1], v[1]), dppo<CTRL>(o[2], v[2]), dppo<CTRL>(o[3], v[3])}; }
struct EpiConv {
    static constexpr bool PERM = true, AFTER_DRAIN = false;
    bf16_t* Y; const float* cw; const float* cb; float* halo; unsigned* flags; PG8_LAS unsigned char* xch; int nN;
    __device__ __forceinline__ void operator()(const f32x4 (&acc)[2][2][4][2], const Unit& u, int wr, int wc, int fr, int fq) const {
        constexpr int NUPc = 11008, DFFc = 5504;
        const int lane = fq * 16 + fr;
        const bool need_prev = (u.pm & 7) != 0;
        if (fr >= 14) {
#pragma unroll
            for (int ai = 0; ai < 2; ++ai)
#pragma unroll
                for (int bj = 0; bj < 2; ++bj)
#pragma unroll
                    for (int n = 0; n < 2; ++n) *(PG8_LAS f32x4*)(xch + ((((ai * 2 + wr) * 4 + wc) * 2 + (fr - 14)) * 64 + bj * 32 + 8 * fq + 4 * n) * 4) = acc[ai][bj][3][n];
            if (wr == 1) { float* hp = halo + ((size_t)(u.pm * nN + u.pn) * 2 + (fr - 14)) * 256 + wc * 32 + 8 * fq;
#pragma unroll
                for (int bj = 0; bj < 2; ++bj)
#pragma unroll
                    for (int n = 0; n < 2; ++n) { const f32x4 v = acc[1][bj][3][n]; unsigned long long* q = (unsigned long long*)(hp + bj * 128 + 4 * n);
                        const float e0 = v[0], e1 = v[1], e2 = v[2], e3 = v[3];
                        __hip_atomic_store(q, ((unsigned long long)__float_as_uint(e1) << 32) | __float_as_uint(e0), __ATOMIC_RELAXED, __HIP_MEMORY_SCOPE_AGENT);
                        __hip_atomic_store(q + 1, ((unsigned long long)__float_as_uint(e3) << 32) | __float_as_uint(e2), __ATOMIC_RELAXED, __HIP_MEMORY_SCOPE_AGENT); } }
        }
        if (wr == 1) { asm volatile("s_waitcnt vmcnt(0)" ::: "memory"); if (lane == 0) __hip_atomic_fetch_add(flags + u.pm * nN + u.pn, 1u, __ATOMIC_RELAXED, __HIP_MEMORY_SCOPE_AGENT); }
        if (need_prev && wr == 0 && wc == 0) {
            const unsigned* fp = flags + (u.pm - 1) * nN + u.pn;
            for (unsigned sp_ = 0; (unsigned)__builtin_amdgcn_readfirstlane(__hip_atomic_load(fp, __ATOMIC_RELAXED, __HIP_MEMORY_SCOPE_AGENT)) < 4u && sp_ < (1u << 22); ++sp_) __builtin_amdgcn_s_sleep(2);
            __builtin_amdgcn_fence(__ATOMIC_ACQUIRE, "agent");
            asm volatile("s_waitcnt vmcnt(0)" ::: "memory");
        }
        asm volatile("s_waitcnt lgkmcnt(0)" ::: "memory"); __builtin_amdgcn_s_barrier(); asm volatile("" ::: "memory");
        u32x2 ypk[2][4];
#pragma unroll
        for (int n = 0; n < 2; ++n) {
            const int fcol = u.pn * 128 + wc * 32 + 8 * fq + 4 * n;
            f32x4 wg[3], wv[3];
#pragma unroll
            for (int j = 0; j < 3; ++j) { wg[j] = *(const f32x4*)(cw + (size_t)j * NUPc + fcol); wv[j] = *(const f32x4*)(cw + (size_t)j * NUPc + DFFc + fcol); }
            const f32x4 bg = *(const f32x4*)(cb + fcol), bv = *(const f32x4*)(cb + DFFc + fcol);
#pragma unroll
            for (int ai = 0; ai < 2; ++ai) {
                f32x4 h1g, h2g, h1v, h2v;
                const int ci = 2 * ai + wr;
                if (ci == 0) {
                    if (need_prev) { const float* hp = halo + ((size_t)((u.pm - 1) * nN + u.pn) * 2) * 256 + wc * 32 + 8 * fq + 4 * n;
                        h2g = ldh(hp); h2v = ldh(hp + 128); h1g = ldh(hp + 256); h1v = ldh(hp + 256 + 128); }
                    else { h1g = h2g = h1v = h2v = (f32x4){0.f, 0.f, 0.f, 0.f}; }
                } else { const int cp = ci - 1; const PG8_LAS unsigned char* xp = xch + ((((cp >> 1) * 2 + (cp & 1)) * 4 + wc) * 2 * 64 + 8 * fq + 4 * n) * 4;
                    h2g = *(const PG8_LAS f32x4*)(xp); h2v = *(const PG8_LAS f32x4*)(xp + 32 * 4); h1g = *(const PG8_LAS f32x4*)(xp + 64 * 4); h1v = *(const PG8_LAS f32x4*)(xp + 64 * 4 + 32 * 4); }
                f32x4 og1 = h1g, ov1 = h1v, og2, ov2;
#pragma unroll
                for (int e = 0; e < 4; ++e) { og2[e] = fr == 1 ? h1g[e] : h2g[e]; ov2[e] = fr == 1 ? h1v[e] : h2v[e]; }
#pragma unroll
                for (int m = 0; m < 4; ++m) {
                    const f32x4 g0 = acc[ai][0][m][n], v0 = acc[ai][1][m][n];
                    const f32x4 g1 = dppo4<0x111>(og1, g0), g2 = dppo4<0x112>(og2, g0), v1 = dppo4<0x111>(ov1, v0), v2 = dppo4<0x112>(ov2, v0);
                    if (m < 3) { og1 = dpp4<0x121>(g0); og2 = dpp4<0x122>(g0); ov1 = dpp4<0x121>(v0); ov2 = dpp4<0x122>(v0); }
                    const f32x4 gt = bg + wg[0] * g2 + wg[1] * g1 + wg[2] * g0, vl = bv + wv[0] * v2 + wv[1] * v1 + wv[2] * v0;
                    u32x2 w; w.x = cvt_pk_bf16(gelu_tanh_f(gt[0]) * vl[0], gelu_tanh_f(gt[1]) * vl[1]); w.y = cvt_pk_bf16(gelu_tanh_f(gt[2]) * vl[2], gelu_tanh_f(gt[3]) * vl[3]);
                    if (n == 0) ypk[ai][m] = w;
                    else { u32x4 o; o.x = ypk[ai][m].x; o.y = ypk[ai][m].y; o.z = w.x; o.w = w.y;
                        *(u32x4*)(Y + (size_t)(u.pm * BM + ai * HALF + wr * 64 + m * 16 + fr) * DFFc + u.pn * 128 + wc * 32 + 8 * fq) = o; }
                }
            }
        }
    }
};
template <class Epi, class Sched, bool ALIGN_EPI = false, bool SP2 = false>
__device__ __forceinline__ void gemm_phase(PG8_LAS unsigned char* lds, const Gemm g, const Sched& S, const Epi& E) {
    const int tid = threadIdx.x, wid = __builtin_amdgcn_readfirstlane(tid >> 6), lane = tid & 63, wr = wid >> 2, wc = wid & 3, fr = lane & 15, fq = lane >> 4;
    const int K = g.K, nt = K / BK;
    unsigned voffA[2], voffB[2];
#pragma unroll
    for (int i = 0; i < 2; ++i) { int R, C; stage_rc(tid * 16 + i * 8192, R, C); const int Rb = Epi::PERM ? ((R & ~31) + perm32(R & 31)) : R;
        voffA[i] = (unsigned)(R * K + C) * 2u; voffB[i] = (unsigned)(Rb * K + C) * 2u; }
    const size_t kstep = (size_t)(BK * 2);
    const size_t hstep = (size_t)HALF * K * 2;
    const size_t tstep = 2 * hstep;
    const unsigned ldsw = (unsigned)wid * 1024u;
    const int aoff = lds_byte(wr * 64 + fr, fq * 8), boff = lds_byte(wc * 32 + fr, fq * 8);
#define PG8_SA(b, h) (((b) * 2 + (h)) * HTB)
#define PG8_SB(b, h) ((4 + (b) * 2 + (h)) * HTB)
#define PG8_STAGE(bufoff, gbase, voff) do { _Pragma("unroll") for (int _i = 0; _i < 2; ++_i) \
        __builtin_amdgcn_global_load_lds((const unsigned*)((const char*)(gbase) + (voff)[_i]), (PG8_LAS unsigned*)(lds + (bufoff) + ldsw + _i * 8192), 16, 0, 0); } while (0)
#define PG8_LDA(dst, b, h) do { _Pragma("unroll") for (int m = 0; m < 4; ++m) _Pragma("unroll") for (int k = 0; k < 2; ++k) dst[m][k] = *(const PG8_LAS bf16x8*)(lds + PG8_SA(b, h) + aoff + m * 2048 + k * 1024); } while (0)
#define PG8_LDB(dst, b, h) do { _Pragma("unroll") for (int n = 0; n < 2; ++n) _Pragma("unroll") for (int k = 0; k < 2; ++k) dst[n][k] = *(const PG8_LAS bf16x8*)(lds + PG8_SB(b, h) + boff + n * 2048 + k * 1024); } while (0)
#define PG8_MMA(ai, bj, At, Bt) do { __builtin_amdgcn_s_setprio(1); _Pragma("unroll") for (int m = 0; m < 4; ++m) _Pragma("unroll") for (int n = 0; n < 2; ++n) _Pragma("unroll") for (int k = 0; k < 2; ++k) \
        acc[ai][bj][m][n] = __builtin_amdgcn_mfma_f32_16x16x32_bf16(Bt[n][k], At[m][k], acc[ai][bj][m][n], 0, 0, 0); __builtin_amdgcn_s_setprio(0); } while (0)
#define PG8_WAIT_V(n) asm volatile("s_waitcnt vmcnt(" #n ")" ::: "memory")
#define PG8_WAIT_L(n) asm volatile("s_waitcnt lgkmcnt(" #n ")" ::: "memory")
#define PG8_BAR __builtin_amdgcn_s_barrier()
#define PG8_SCHED __builtin_amdgcn_sched_barrier(0)
    Unit cur, nxt; int ui = 0;
    if (!S.next(0, cur)) return;
    f32x4 acc[2][2][4][2];
#pragma unroll
    for (int a = 0; a < 2; ++a)
#pragma unroll
        for (int b = 0; b < 2; ++b)
#pragma unroll
            for (int m = 0; m < 4; ++m)
#pragma unroll
                for (int n = 0; n < 2; ++n) acc[a][b][m][n] = (f32x4){0.f, 0.f, 0.f, 0.f};
    bf16x8 At[4][2], B0[2][2], B1[2][2];
    const char* cA = (const char*)g.A + (size_t)cur.pm * tstep; const char* cB = (const char*)g.Bt + (size_t)cur.pn * tstep;
    S.a_ready(cur);
    if constexpr (SP2) {
        PG8_STAGE(PG8_SB(0, 0), cB, voffB); PG8_STAGE(PG8_SB(0, 1), cB + hstep, voffB); PG8_STAGE(PG8_SA(0, 0), cA, voffA); PG8_STAGE(PG8_SA(0, 1), cA + hstep, voffA);
        if (wr == 1) PG8_BAR;
        PG8_WAIT_V(2); PG8_BAR;
        PG8_STAGE(PG8_SB(1, 0), cB + kstep, voffB); PG8_STAGE(PG8_SA(1, 0), cA + kstep, voffA); PG8_STAGE(PG8_SB(1, 1), cB + hstep + kstep, voffB);
        PG8_WAIT_V(6); PG8_BAR;
    } else {
        PG8_STAGE(PG8_SB(0, 0), cB, voffB); PG8_STAGE(PG8_SA(0, 0), cA, voffA); PG8_STAGE(PG8_SB(0, 1), cB + hstep, voffB); PG8_STAGE(PG8_SA(0, 1), cA + hstep, voffA);
        if (wr == 1) PG8_BAR;
        PG8_WAIT_V(4); PG8_BAR;
        PG8_STAGE(PG8_SB(1, 0), cB + kstep, voffB); PG8_STAGE(PG8_SA(1, 0), cA + kstep, voffA); PG8_STAGE(PG8_SB(1, 1), cB + hstep + kstep, voffB);
        PG8_WAIT_V(6); PG8_BAR;
    }
    for (;;) {
        const bool has_next = S.next(ui + 1, nxt);
        const char* nA = has_next ? (const char*)g.A + (size_t)nxt.pm * tstep : cA; const char* nB = has_next ? (const char*)g.Bt + (size_t)nxt.pn * tstep : cB;
        for (int t = 0; t < nt; t += 2) {
            const bool last = (t == nt - 2);
            const char* a1 = cA + (size_t)(t + 1) * kstep;
            const char* a2 = last ? nA : cA + (size_t)(t + 2) * kstep; const char* b2 = last ? nB : cB + (size_t)(t + 2) * kstep;
            const char* a3 = a2 + kstep; const char* b3 = b2 + kstep;
            if (last && has_next) S.a_ready(nxt);
            if constexpr (SP2) {
            PG8_LDB(B0, 0, 0); PG8_LDB(B1, 0, 1); PG8_SCHED; PG8_LDA(At, 0, 0); PG8_STAGE(PG8_SA(1, 1), a1 + hstep, voffA);
            PG8_WAIT_V(8); PG8_WAIT_L(0); PG8_BAR; PG8_MMA(0, 0, At, B0); PG8_MMA(0, 1, At, B1); PG8_BAR; PG8_SCHED;
            PG8_LDA(At, 0, 1); PG8_STAGE(PG8_SB(0, 0), b2, voffB); PG8_STAGE(PG8_SB(0, 1), b2 + hstep, voffB); PG8_STAGE(PG8_SA(0, 0), a2, voffA);
            PG8_WAIT_V(8); PG8_WAIT_L(0); PG8_BAR; PG8_MMA(1, 0, At, B0); PG8_MMA(1, 1, At, B1); PG8_BAR; PG8_SCHED;
            PG8_LDB(B0, 1, 0); PG8_LDB(B1, 1, 1); PG8_SCHED; PG8_LDA(At, 1, 0); PG8_STAGE(PG8_SA(0, 1), a2 + hstep, voffA);
            PG8_WAIT_V(8); PG8_WAIT_L(0); PG8_BAR; PG8_MMA(0, 0, At, B0); PG8_MMA(0, 1, At, B1); PG8_BAR; PG8_SCHED;
            PG8_LDA(At, 1, 1); PG8_STAGE(PG8_SB(1, 0), b3, voffB); PG8_STAGE(PG8_SB(1, 1), b3 + hstep, voffB); PG8_STAGE(PG8_SA(1, 0), a3, voffA);
            PG8_WAIT_V(8); PG8_WAIT_L(0); PG8_BAR; PG8_MMA(1, 0, At, B0); PG8_MMA(1, 1, At, B1); PG8_BAR; PG8_SCHED;
            } else {
            PG8_LDB(B0, 0, 0); PG8_SCHED; PG8_LDA(At, 0, 0); PG8_STAGE(PG8_SA(1, 1), a1 + hstep, voffA);
            PG8_WAIT_L(8); PG8_BAR; PG8_WAIT_L(0); PG8_MMA(0, 0, At, B0); PG8_BAR; PG8_SCHED;
            PG8_LDB(B1, 0, 1); PG8_STAGE(PG8_SB(0, 0), b2, voffB);
            PG8_BAR; PG8_WAIT_L(0); PG8_MMA(0, 1, At, B1); PG8_BAR;
            PG8_LDA(At, 0, 1); PG8_STAGE(PG8_SA(0, 0), a2, voffA);
            PG8_BAR; PG8_WAIT_L(0); PG8_MMA(1, 0, At, B0); PG8_BAR; PG8_SCHED;
            PG8_STAGE(PG8_SB(0, 1), b2 + hstep, voffB);
            PG8_WAIT_V(6); PG8_BAR; PG8_MMA(1, 1, At, B1); PG8_BAR;
            PG8_LDB(B0, 1, 0); PG8_SCHED; PG8_LDA(At, 1, 0); PG8_STAGE(PG8_SA(0, 1), a2 + hstep, voffA);
            PG8_WAIT_L(8); PG8_BAR; PG8_WAIT_L(0); PG8_MMA(0, 0, At, B0); PG8_BAR; PG8_SCHED;
            PG8_LDB(B1, 1, 1); PG8_STAGE(PG8_SB(1, 0), b3, voffB);
            PG8_BAR; PG8_WAIT_L(0); PG8_MMA(0, 1, At, B1); PG8_BAR;
            PG8_LDA(At, 1, 1); PG8_STAGE(PG8_SA(1, 0), a3, voffA);
            PG8_BAR; PG8_WAIT_L(0); PG8_MMA(1, 0, At, B0); PG8_BAR; PG8_SCHED;
            PG8_STAGE(PG8_SB(1, 1), b3 + hstep, voffB);
            PG8_WAIT_V(6); PG8_BAR; PG8_MMA(1, 1, At, B1); PG8_BAR;
            }
        }
        if constexpr (ALIGN_EPI) { if (wr == 0) PG8_BAR; }
        if constexpr (!Epi::AFTER_DRAIN) { E(acc, cur, wr, wc, fr, fq); S.done(cur); }
        if (!has_next) break;
#pragma unroll
        for (int a = 0; a < 2; ++a)
#pragma unroll
            for (int b = 0; b < 2; ++b)
#pragma unroll
                for (int m = 0; m < 4; ++m)
#pragma unroll
                    for (int n = 0; n < 2; ++n) acc[a][b][m][n] = (f32x4){0.f, 0.f, 0.f, 0.f};
        cur = nxt; cA = nA; cB = nB; ++ui;
        if constexpr (ALIGN_EPI) { if (wr == 1) PG8_BAR; }
    }
    PG8_WAIT_V(0);
    if constexpr (!ALIGN_EPI) { if (wr == 0) PG8_BAR; }
    PG8_BAR;
    if constexpr (Epi::AFTER_DRAIN) { E.fused(acc, cur, wr, wc, fr, fq, lds, wid, lane); S.done(cur); }
#undef PG8_SA
#undef PG8_SB
#undef PG8_STAGE
#undef PG8_LDA
#undef PG8_LDB
#undef PG8_MMA
#undef PG8_WAIT_V
#undef PG8_WAIT_L
#undef PG8_BAR
#undef PG8_SCHED
}
}
using pg8::bf16_t; using pg8::bf16x8; using pg8::f32x4; using pg8::u32x4;
#define LAS __attribute__((address_space(3)))
typedef float f32x16 __attribute__((ext_vector_type(16)));
using pg8::u32x2;
typedef short s16x4 __attribute__((ext_vector_type(4)));

constexpr int SEQ = 2048, BATCH = 8, M = BATCH * SEQ, D = 2048, NQKV = 6144, DFF = 5504, NUP = 2 * DFF, HD = 128;
constexpr float RMS_EPS = 1e-6f;
constexpr float C2 = 0.08838834764831845f * 1.4426950408889634f;
constexpr int NWAVES = 8, NTHREADS = 512;
constexpr int MHALF = M / 2;
constexpr size_t MiB = 1u << 20;
constexpr size_t WS_ROPE = 1 * MiB;
constexpr size_t WS_WIN = 2 * MiB, WS_WOUT = 26 * MiB, WS_WUP = 34 * MiB, WS_WDOWN = 77 * MiB;
constexpr size_t WS_XN = 100 * MiB;
constexpr size_t WS_OB2 = 100 * MiB, WS_LSE = 132 * MiB;
constexpr size_t WS_QKV = 164 * MiB;
constexpr size_t WS_MIXED = 356 * MiB;
constexpr size_t WS_MIXOUT = 420 * MiB;
constexpr size_t WS_OB0 = 420 * MiB, WS_OB1 = 452 * MiB;
constexpr size_t WS_Y = 164 * MiB;
constexpr size_t WS_HALO = 340 * MiB;
constexpr size_t WS_BAR = 65536;
constexpr size_t WS_RSTD1 = 348 * MiB;
constexpr size_t WS_FLAGS = 0;
constexpr size_t WS_END = 484 * MiB;
constexpr int RING_BYTES = 131072, XCH_OFF = RING_BYTES, LDS_BYTES = RING_BYTES + 8192 + 4096;

__device__ __forceinline__ u32x4 ldntu4(const u32x4* p) { return __builtin_nontemporal_load(p); }
__device__ __forceinline__ u32x2 ldntu2(const u32x2* p) { return __builtin_nontemporal_load(p); }
__device__ __forceinline__ f32x4 ldnt4(const f32x4* p) { return __builtin_nontemporal_load(p); }
__device__ __forceinline__ void stnt4(f32x4* p, f32x4 v) { __builtin_nontemporal_store(v, p); }
__device__ __forceinline__ float wave_sum(float v) {
#pragma unroll
    for (int o = 1; o < 64; o <<= 1) v += __shfl_xor(v, o);
    return v;
}
__device__ __forceinline__ unsigned f2bf(float f) { unsigned u = __builtin_bit_cast(unsigned, f); return (u + 0x7fffu + ((u >> 16) & 1u)) >> 16; }
__device__ __forceinline__ unsigned pk2(float lo, float hi) { unsigned r; asm("v_cvt_pk_bf16_f32 %0, %1, %2" : "=v"(r) : "v"(lo), "v"(hi)); return r; }
__device__ __forceinline__ float bf_lo(unsigned w) { return __builtin_bit_cast(float, w << 16); }
__device__ __forceinline__ float bf_hi(unsigned w) { return __builtin_bit_cast(float, w & 0xffff0000u); }

__device__ __forceinline__ int win_rowmap(int n) { const int seg = n >> 10; if (seg == 3 || seg == 4) { const int w = n & 1023, hh = w >> 7, d = w & 127; return (seg << 10) + (hh << 7) + 2 * (d & 63) + (d >> 6); } return n; }
__device__ __forceinline__ int up_rowmap(int n) { const int f = n < DFF ? n : n - DFF; return (f >> 7) * 256 + (n < DFF ? 0 : 128) + (f & 127); }
template <int MAP> __device__ __forceinline__ void p0_transpose_item(const float* __restrict__ W, int K, int N, bf16_t* WT, LAS float* scr, int item, int lane) {
    const int nblk = N / 32, kb = item / nblk, nb = item % nblk, k0 = 64 * kb, n0 = 32 * nb;
#pragma unroll 8
    for (int i = 0; i < 32; ++i) { const int kk = 2 * i + (lane >> 5); scr[kk * 33 + (lane & 31)] = __builtin_nontemporal_load(W + (size_t)(k0 + kk) * N + n0 + (lane & 31)); }
    asm volatile("s_waitcnt lgkmcnt(0)" ::: "memory");
    const int c = lane & 7;
#pragma unroll
    for (int j = 0; j < 4; ++j) { const int n = (lane >> 3) + 8 * j; const LAS float* s = scr + (8 * c) * 33 + n;
        u32x4 o; o.x = pk2(s[0 * 33], s[1 * 33]); o.y = pk2(s[2 * 33], s[3 * 33]); o.z = pk2(s[4 * 33], s[5 * 33]); o.w = pk2(s[6 * 33], s[7 * 33]);
        const int drow = MAP == 1 ? win_rowmap(n0 + n) : (MAP == 2 ? up_rowmap(n0 + n) : (n0 + n));
        *(u32x4*)(WT + (size_t)drow * K + k0 + 8 * c) = o; }
    asm volatile("s_waitcnt lgkmcnt(0)" ::: "memory");
}
__device__ __forceinline__ void rms_row_to_bf16(const float* xrow, const float* gain, bf16_t* orow, int lane) {
    const f32x4* xr = (const f32x4*)xrow + lane; f32x4 v[8]; float s = 0.f;
#pragma unroll
    for (int j = 0; j < 8; ++j) { v[j] = ldnt4(xr + 64 * j); s += (v[j][0] * v[j][0] + v[j][1] * v[j][1]) + (v[j][2] * v[j][2] + v[j][3] * v[j][3]); }
    const float rstd = 1.f / sqrtf(wave_sum(s) * (1.f / D) + RMS_EPS);
    const f32x4* gr = (const f32x4*)gain + lane; u32x2* o8 = (u32x2*)orow + lane;
#pragma unroll
    for (int j = 0; j < 8; ++j) { const f32x4 g = gr[64 * j]; u32x2 w; w.x = pk2(v[j][0] * rstd * g[0], v[j][1] * rstd * g[1]); w.y = pk2(v[j][2] * rstd * g[2], v[j][3] * rstd * g[3]); o8[64 * j] = w; }
}

namespace att {
constexpr int KST = 272, VST = 320, KTB = 64 * KST, VTB = 64 * VST, BUFB = KTB + VTB;
constexpr int PITCH = NQKV;
constexpr float SB_DONE_BITS = 48.f;
__device__ __forceinline__ constexpr int crow(int r, int hi) { return (r & 3) + 8 * (r >> 2) + 4 * hi; }
struct HalfPair { float lo, up; };
__device__ __forceinline__ HalfPair xhalf(float v) { const auto rr = __builtin_amdgcn_permlane32_swap(__float_as_uint(v), __float_as_uint(v), false, false); return HalfPair{__uint_as_float(rr[0]), __uint_as_float(rr[1])}; }
__device__ __forceinline__ float xhalf_sum(float v) { const HalfPair h = xhalf(v); return h.lo + h.up; }
__device__ __forceinline__ float xhalf_max(float v) { const HalfPair h = xhalf(v); return __builtin_fmaxf(h.lo, h.up); }
__device__ __forceinline__ s16x4 vtr(const LAS unsigned char* p) { return __builtin_bit_cast(s16x4, __builtin_amdgcn_ds_read_tr16_b64_v4i16((LAS s16x4*)p)); }

template <int KIND> __device__ __forceinline__ void subblock(const LAS unsigned char* kt, const LAS unsigned char* vt, const bf16x8 (&qf)[8], f32x16 (&o)[4], float& st0, float& st1, const int mask, const int r32, const int hi, const int lane) {
    f32x16 z = {0.f, 0.f, 0.f, 0.f, 0.f, 0.f, 0.f, 0.f, 0.f, 0.f, 0.f, 0.f, 0.f, 0.f, 0.f, 0.f}, z1 = z;
    const LAS unsigned char* kp = kt + r32 * KST + hi * 16;
#pragma unroll
    for (int d0 = 0; d0 < 8; d0 += 2) { const bf16x8 kf = *(const LAS bf16x8*)(kp + d0 * 32), kg = *(const LAS bf16x8*)(kp + d0 * 32 + 32);
        z = __builtin_amdgcn_mfma_f32_32x32x16_bf16(kf, qf[d0], z, 0, 0, 0); z1 = __builtin_amdgcn_mfma_f32_32x32x16_bf16(kg, qf[d0 + 1], z1, 0, 0, 0); }
    z = z + z1;
    float p[16];
    if (KIND == 0) {
        float L[16];
#pragma unroll
        for (int r = 0; r < 16; ++r) { const float zz = __builtin_fminf(z[r], 120.f); const float e = __builtin_amdgcn_exp2f(zz); float l2 = __builtin_amdgcn_logf(1.f + e);
            if (mask == 1 && !(crow(r, hi) < r32)) l2 = 0.f; L[r] = l2; }
        HalfPair gp[4];
#pragma unroll
        for (int i = 0; i < 4; ++i) gp[i] = xhalf((L[4 * i] + L[4 * i + 1]) + (L[4 * i + 2] + L[4 * i + 3]));
        float t[4]; t[3] = 0.f; t[2] = gp[3].lo + gp[3].up; t[1] = t[2] + (gp[2].lo + gp[2].up); t[0] = t[1] + (gp[1].lo + gp[1].up);
        const float T = t[0] + (gp[0].lo + gp[0].up);
#pragma unroll
        for (int i = 0; i < 4; ++i) { const float b = st0 + t[i] + (hi == 0 ? gp[i].up : 0.f);
            const float w3 = b + L[4 * i + 3], w2 = w3 + L[4 * i + 2], w1 = w2 + L[4 * i + 1], w0 = w1 + L[4 * i + 0];
            p[4 * i + 0] = z[4 * i + 0] - w0; p[4 * i + 1] = z[4 * i + 1] - w1; p[4 * i + 2] = z[4 * i + 2] - w2; p[4 * i + 3] = z[4 * i + 3] - w3; }
#pragma unroll
        for (int r = 0; r < 16; ++r) { float a = __builtin_amdgcn_exp2f(p[r]); if (mask == 1 && !(crow(r, hi) < r32)) a = 0.f; p[r] = a; }
        st0 += T;
    } else {
        float rm = -INFINITY;
#pragma unroll
        for (int r = 0; r < 16; ++r) { float zz = z[r]; if (mask == 1 && crow(r, hi) > r32) zz = -INFINITY; if (mask == 2 && crow(r, hi) < r32) zz = -INFINITY; p[r] = zz; rm = __builtin_fmaxf(rm, zz); }
        rm = xhalf_max(rm);
        if (__any(rm > st0 + 8.f)) { const float mn = __builtin_fmaxf(st0, rm); const float alpha = __builtin_amdgcn_exp2f(st0 - mn); st0 = mn; st1 *= alpha;
#pragma unroll
            for (int d0 = 0; d0 < 4; ++d0) o[d0] = o[d0] * alpha; }
        float s = 0.f;
#pragma unroll
        for (int r = 0; r < 16; ++r) { p[r] = __builtin_amdgcn_exp2f(p[r] - st0); s += p[r]; }
        st1 += s;
    }
    u32x4 pw0, pw1;
    pw0.x = pg8::cvt_pk_bf16(p[0], p[1]); pw0.y = pg8::cvt_pk_bf16(p[2], p[3]); pw0.z = pg8::cvt_pk_bf16(p[4], p[5]); pw0.w = pg8::cvt_pk_bf16(p[6], p[7]);
    pw1.x = pg8::cvt_pk_bf16(p[8], p[9]); pw1.y = pg8::cvt_pk_bf16(p[10], p[11]); pw1.z = pg8::cvt_pk_bf16(p[12], p[13]); pw1.w = pg8::cvt_pk_bf16(p[14], p[15]);
    const bf16x8 pa0 = __builtin_bit_cast(bf16x8, pw0), pa1 = __builtin_bit_cast(bf16x8, pw1);
    const LAS unsigned char* vp = vt + (4 * hi + ((lane & 15) >> 2)) * VST + ((lane >> 4) & 1) * 32 + (lane & 3) * 8;
#pragma unroll
    for (int d0 = 0; d0 < 4; ++d0) {
        const s16x4 a0 = vtr(vp + d0 * 64), a1 = vtr(vp + d0 * 64 + 8 * VST), b0 = vtr(vp + d0 * 64 + 16 * VST), b1 = vtr(vp + d0 * 64 + 24 * VST);
        const bf16x8 va = (bf16x8){a0[0], a0[1], a0[2], a0[3], a1[0], a1[1], a1[2], a1[3]}, vb = (bf16x8){b0[0], b0[1], b0[2], b0[3], b1[0], b1[1], b1[2], b1[3]};
        o[d0] = __builtin_amdgcn_mfma_f32_32x32x16_bf16(va, pa0, o[d0], 0, 0, 0);
        o[d0] = __builtin_amdgcn_mfma_f32_32x32x16_bf16(vb, pa1, o[d0], 0, 0, 0);
    }
}

template <int KIND> __device__ __forceinline__ void attn_unit(LAS unsigned char* lds, const bf16_t* __restrict__ QKV, int rb, int dil, int res0, int isplit, int nt, int ks_first, int kstep,
                                                             int res_w, int lw0, int qcol, int kcol, int vcol, bf16_t* Out, int out_pitch, int ocol, const float* gain, float* lse_out) {
    const int tid = threadIdx.x, lane = tid & 63, r32 = lane & 31, hi = lane >> 5;
    const int tq = rb + (lw0 + r32) * dil + res_w;
    bf16x8 qf[8];
    { const bf16_t* qp = QKV + (size_t)tq * PITCH + qcol + hi * 8;
#pragma unroll
      for (int d0 = 0; d0 < 8; ++d0) qf[d0] = *(const bf16x8*)(qp + d0 * 16); }
    f32x16 o[4];
#pragma unroll
    for (int d0 = 0; d0 < 4; ++d0) o[d0] = (f32x16){0.f, 0.f, 0.f, 0.f, 0.f, 0.f, 0.f, 0.f, 0.f, 0.f, 0.f, 0.f, 0.f, 0.f, 0.f, 0.f};
    float st0 = (KIND == 0) ? 0.f : -INFINITY, st1 = 0.f;
    const int srow = tid >> 4, sch = tid & 15;
    u32x4 krA[2], vrA[2], krB[2], vrB[2];
#define ATT_TILE_GEOM(i, res_i, ks_i) const int sp_ = ((i) >= isplit) ? 1 : 0; const int res_i = res0 + sp_; const int ks_i = ks_first + kstep * ((i) - (sp_ ? isplit : 0));
#define ATT_LOAD(i, KR, VR) do { ATT_TILE_GEOM(i, res_i, ks_i) _Pragma("unroll") for (int c = 0; c < 2; ++c) { const int tok = rb + (ks_i + srow + 32 * c) * dil + res_i; const bf16_t* p = QKV + (size_t)tok * PITCH + sch * 8; \
        KR[c] = *(const u32x4*)(p + kcol); VR[c] = *(const u32x4*)(p + vcol); } } while (0)
#define ATT_STORE(buf, KR, VR) do { _Pragma("unroll") for (int c = 0; c < 2; ++c) { *(LAS u32x4*)(lds + (buf) * BUFB + (srow + 32 * c) * KST + sch * 16) = KR[c]; *(LAS u32x4*)(lds + (buf) * BUFB + KTB + (srow + 32 * c) * VST + sch * 16) = VR[c]; } } while (0)
#define ATT_ITER(i, KRA, VRA, KRB, VRB) do { \
        { const int ip_ = ((i) + 2 < nt) ? (i) + 2 : nt - 1; ATT_LOAD(ip_, KRB, VRB); }     \
        { ATT_TILE_GEOM(i, res_i, ks_i) \
          const bool wdone_ = (KIND == 0) && __all(st0 > SB_DONE_BITS);     \
          if (res_i == res_w && !wdone_) { \
            const LAS unsigned char* kb = lds + ((i) & 1) * BUFB; const LAS unsigned char* vb = kb + KTB; \
            _Pragma("unroll") for (int ss = 0; ss < 2; ++ss) { const int sub = (KIND == 0) ? 1 - ss : ss; const int kss = ks_i + 32 * sub; \
                const bool need = (kss <= lw0) && (KIND == 0 || kss >= lw0 - 128); \
                if (need) { const int mask = (kss == lw0) ? 1 : ((KIND == 1 && kss == lw0 - 128) ? 2 : 0); \
                    subblock<KIND>(kb + sub * 32 * KST, vb + sub * 32 * VST, qf, o, st0, st1, mask, r32, hi, lane); } } \
          } } \
        if (KIND == 0) { const int dn_ = __all(st0 > SB_DONE_BITS) ? 1 : 0; if (lane == 0) dflag[((i) & 1) * 8 + wid] = dn_; } \
        ATT_STORE(((i) + 1) & 1, KRA, VRA);     \
        __syncthreads(); \
        if (KIND == 0) { const u32x4 fa_ = *(const LAS u32x4*)(dflag + ((i) & 1) * 8), fb_ = *(const LAS u32x4*)(dflag + ((i) & 1) * 8 + 4); \
            stop_ = (fa_.x & fa_.y & fa_.z & fa_.w & fb_.x & fb_.y & fb_.z & fb_.w) != 0u; } } while (0)
    ATT_LOAD(0, krA, vrA); ATT_STORE(0, krA, vrA); ATT_LOAD(1, krA, vrA); __syncthreads();
    LAS unsigned* dflag = (LAS unsigned*)(lds + 2 * BUFB); const int wid = tid >> 6; bool stop_ = false;
    for (int i = 0; i < nt; i += 2) { ATT_ITER(i, krA, vrA, krB, vrB); if (stop_) break; ATT_ITER(i + 1, krB, vrB, krA, vrA); if (stop_) break; }
    if (KIND == 0) __syncthreads();
#undef ATT_ITER
#undef ATT_LOAD
#undef ATT_STORE
#undef ATT_TILE_GEOM
    bf16_t* orow = Out + (size_t)tq * out_pitch + ocol + 4 * hi;
    if (KIND == 0) {
        float ss = 0.f;
#pragma unroll
        for (int d0 = 0; d0 < 4; ++d0)
#pragma unroll
            for (int r = 0; r < 16; ++r) ss += o[d0][r] * o[d0][r];
        ss = xhalf_sum(ss);
        const float rstd = 1.f / sqrtf(ss * (1.f / HD) + RMS_EPS);
#pragma unroll
        for (int d0 = 0; d0 < 4; ++d0)
#pragma unroll
            for (int i4 = 0; i4 < 4; ++i4) { const f32x4 g = *(const f32x4*)(gain + ocol + 32 * d0 + 8 * i4 + 4 * hi);
                u32x2 w; w.x = pk2(o[d0][4 * i4] * rstd * g[0], o[d0][4 * i4 + 1] * rstd * g[1]); w.y = pk2(o[d0][4 * i4 + 2] * rstd * g[2], o[d0][4 * i4 + 3] * rstd * g[3]);
                *(u32x2*)(orow + 32 * d0 + 8 * i4) = w; }
    } else {
        const float l = xhalf_sum(st1); const float inv = 1.f / l;
#pragma unroll
        for (int d0 = 0; d0 < 4; ++d0)
#pragma unroll
            for (int i4 = 0; i4 < 4; ++i4) { u32x2 w; w.x = pk2(o[d0][4 * i4] * inv, o[d0][4 * i4 + 1] * inv); w.y = pk2(o[d0][4 * i4 + 2] * inv, o[d0][4 * i4 + 3] * inv);
                *(u32x2*)(orow + 32 * d0 + 8 * i4) = w; }
        if (hi == 0) lse_out[(size_t)tq * 8 + (ocol >> 7)] = st0 + __builtin_amdgcn_logf(l);
    }
}
}

__device__ __forceinline__ float gelu_tanh(float x) { const float t = x * (1.f + 0.044715f * x * x) * 2.3022081983f; return x / (1.f + __builtin_amdgcn_exp2f(-t)); }

#define XB_TMO      128
#define XB_XCNT(j)  (256  + 64 * (j))
#define XB_XSUB(j)  (1280 + 64 * (j))
#define XB_XGEN(j)  (2304 + 64 * (j))
#define XB_TOP      3328
#define XB_TOPGEN   3392
#define XCD_BAR_WORDS 3456
#define XB_SPIN_CAP (1u << 18)

__device__ __forceinline__ unsigned xb_ld(unsigned* p)              { return __hip_atomic_load(p, __ATOMIC_RELAXED, __HIP_MEMORY_SCOPE_AGENT); }
__device__ __forceinline__ unsigned xb_add(unsigned* p, unsigned v) { return __hip_atomic_fetch_add(p, v, __ATOMIC_RELAXED, __HIP_MEMORY_SCOPE_AGENT); }
__device__ __forceinline__ unsigned xb_xcc_id() { return (unsigned)__builtin_amdgcn_s_getreg((3 << 11) | 20) & 0xFu; }
#define XB_SPIN(cond, bar) do { unsigned _sp = 0; while (cond) { __builtin_amdgcn_s_sleep(1); \
    if ((++_sp & 255u) == 0u) { if (xb_ld(&(bar)[XB_TMO])) break; if (_sp > XB_SPIN_CAP) { atomicAdd(&(bar)[XB_TMO], 1u); break; } } } } while (0)

struct XcdBarrier {
    unsigned* bar; unsigned x;
    volatile LAS unsigned* st;
};

__device__ __forceinline__ XcdBarrier xcd_barrier_post(unsigned* bar, volatile LAS unsigned* st) {
    XcdBarrier b; b.bar = bar; b.x = xb_xcc_id(); b.st = st;
    if (threadIdx.x == 0) (void)xb_add(&bar[XB_XCNT(b.x)], 1u);
    return b;
}
__device__ __forceinline__ void xcd_barrier_complete(unsigned* bar, unsigned x, unsigned& nloc, unsigned& nx) {
    const unsigned G = gridDim.x * gridDim.y * gridDim.z;
    unsigned sum, cnt, mine, sp = 0u;
    for (;;) {
        sum = 0u; cnt = 0u; mine = 0u;
#pragma unroll
        for (unsigned j = 0; j < 16; ++j) { const unsigned c = xb_ld(&bar[XB_XCNT(j)]); sum += c; cnt += (c > 0u) ? 1u : 0u; mine = (j == x) ? c : mine; }
        if (sum == G) break;
        __builtin_amdgcn_s_sleep(1);
        if ((++sp & 255u) == 0u) { if (xb_ld(&bar[XB_TMO])) break; if (sp > XB_SPIN_CAP) { atomicAdd(&bar[XB_TMO], 1u); break; } }
    }
    nloc = mine > 0u ? mine : 1u; nx = cnt > 0u ? cnt : 1u;
}

__device__ __forceinline__ void xcd_barrier(const XcdBarrier& b) {
    asm volatile("s_waitcnt vmcnt(0)" ::: "memory");
    __syncthreads();
    if (threadIdx.x == 0) {
        unsigned* bar = b.bar;
        __builtin_amdgcn_s_waitcnt(0);
        unsigned nloc = b.st[0], nx = b.st[1];
        if (nloc == 0u) { xcd_barrier_complete(bar, b.x, nloc, nx); b.st[0] = nloc; b.st[1] = nx; }
        const unsigned old = xb_add(&bar[XB_XSUB(b.x)], 1u);
        const unsigned gen = old / nloc;
        if (old + 1u == (gen + 1u) * nloc) {
            __builtin_amdgcn_fence(__ATOMIC_RELEASE, "agent");
            asm volatile("s_waitcnt vmcnt(0)" ::: "memory");
            const unsigned og = xb_add(&bar[XB_TOP], 1u);
            const unsigned tg = og / nx;
            if (og + 1u == (tg + 1u) * nx) xb_add(&bar[XB_TOPGEN], 1u);
            else XB_SPIN(xb_ld(&bar[XB_TOPGEN]) == tg, bar);
            __builtin_amdgcn_fence(__ATOMIC_ACQUIRE, "agent");
            xb_add(&bar[XB_XGEN(b.x)], 1u);
            asm volatile("s_waitcnt vmcnt(0)" ::: "memory");
        } else {
            XB_SPIN(xb_ld(&bar[XB_XGEN(b.x)]) == gen, bar);
            __builtin_amdgcn_fence(__ATOMIC_ACQUIRE, "agent");
            asm volatile("s_waitcnt vmcnt(0)" ::: "memory");
        }
    }
    __syncthreads();
}

struct Args { const float* in[13]; float* out; unsigned char* ws; int ph_lo, ph_hi; };
constexpr int N_PHASES = 9;
#ifndef DUP_P1
#define DUP_P1 1
#endif
#ifndef DUP_P6
#define DUP_P6 1
#endif
#ifndef DUP_SB
#define DUP_SB 1
#endif
#ifndef DUP_DL
#define DUP_DL 1
#endif
#ifndef DUP_SB
#define DUP_SB 1
#endif
#ifndef DUP_DL
#define DUP_DL 1
#endif
#ifndef DUP_P3
#define DUP_P3 1
#endif
#ifndef DUP_P5
#define DUP_P5 1
#endif
#ifndef DUP_P8
#define DUP_P8 1
#endif
#ifndef DUP_P0
#define DUP_P0 1
#endif
#ifndef DUP_P2
#define DUP_P2 1
#endif

__global__ void __launch_bounds__(NTHREADS, 2) fwd_kernel(Args args) {
    extern __shared__ __attribute__((aligned(16))) unsigned char lds_raw[];
    LAS unsigned char* lds = (LAS unsigned char*)lds_raw;
    cg::grid_group grid = cg::this_grid();
    const int tid = threadIdx.x, lane = tid & 63, wave = __builtin_amdgcn_readfirstlane(tid >> 6);
    const int G = gridDim.x, bx = blockIdx.x;
    const int gw = bx * NWAVES + wave, NGW = G * NWAVES;
    const int lo = args.ph_lo, hi_ph = args.ph_hi;
    unsigned char* ws = args.ws;
    const float* x = args.in[0]; const float* g_pre_mix = args.in[1]; const float* g_post_mix = args.in[2]; const float* g_pre_ffn = args.in[3]; const float* g_post_ffn = args.in[4];
    const float* w_in = args.in[5]; const float* g_sb = args.in[6]; const float* g_dil = args.in[7]; const float* w_out = args.in[8]; const float* w_up = args.in[9];
    const float* conv_w = args.in[10]; const float* conv_b = args.in[11]; const float* w_down = args.in[12];
    float* out = args.out;
    bf16_t* Win_t = (bf16_t*)(ws + WS_WIN); bf16_t* Wout_t = (bf16_t*)(ws + WS_WOUT); bf16_t* Wup_t = (bf16_t*)(ws + WS_WUP); bf16_t* Wdown_t = (bf16_t*)(ws + WS_WDOWN);
    bf16_t* XN = (bf16_t*)(ws + WS_XN); bf16_t* QKV = (bf16_t*)(ws + WS_QKV); bf16_t* MIXED = (bf16_t*)(ws + WS_MIXED); bf16_t* MIXOUT = (bf16_t*)(ws + WS_MIXOUT);
    bf16_t* OB0 = (bf16_t*)(ws + WS_OB0); bf16_t* OB1 = (bf16_t*)(ws + WS_OB1); bf16_t* OB2 = (bf16_t*)(ws + WS_OB2); float* LSE = (float*)(ws + WS_LSE);
    float* HALO = (float*)(ws + WS_HALO); unsigned* FLAGS = (unsigned*)(ws + WS_FLAGS); bf16_t* Y = (bf16_t*)(ws + WS_Y); float* RSTD1 = (float*)(ws + WS_RSTD1); bf16_t* F = (bf16_t*)(ws + WS_XN); float* ROPE = (float*)(ws + WS_ROPE);
    volatile LAS unsigned* bar_st = (volatile LAS unsigned*)(lds + XCH_OFF + 8192);
    if (tid < 2) bar_st[tid] = 0u;
    __syncthreads();
    unsigned* BAR = (unsigned*)(ws + WS_BAR);
    XcdBarrier xbar = xcd_barrier_post(BAR, bar_st);
    if (args.ph_hi > 1000) grid.sync();
#define IN(k) (lo <= (k) && (k) < hi_ph)
#define SEAM(k) do { if (IN(k) && IN((k) + 1)) xcd_barrier(xbar); } while (0)

    for (int rep_ = 0; rep_ < DUP_P0; ++rep_) if (IN(0)) {
        LAS float* scr = (LAS float*)(lds + wave * 16384);
        constexpr int I_IN = (D / 64) * (NQKV / 32), I_OUT = (D / 64) * (D / 32), I_UP = (D / 64) * (NUP / 32), I_DN = (DFF / 64) * (D / 32);
        constexpr int NITEMS = I_IN + I_OUT + I_UP; (void)I_DN;
        for (int it = gw; it < NITEMS; it += NGW) {
            int r = it;
            if (r < I_IN) { p0_transpose_item<1>(w_in, D, NQKV, Win_t, scr, r, lane); continue; } r -= I_IN;
            if (r < I_OUT) { p0_transpose_item<0>(w_out, D, D, Wout_t, scr, r, lane); continue; } r -= I_OUT;
            p0_transpose_item<2>(w_up, D, NUP, Wup_t, scr, r, lane);
        }
        for (int e = bx * NTHREADS + tid; e < SEQ * 64; e += G * NTHREADS) { const int pos = e >> 6, i = e & 63;
            const float inv_freq = exp2f(-(float)i * (13.287712379549449f / 64.f));
            const float ang = (float)pos * inv_freq; float rev = ang * 0.15915494309189535f; rev = rev - floorf(rev);
            ROPE[2 * e] = __builtin_amdgcn_cosf(rev); ROPE[2 * e + 1] = __builtin_amdgcn_sinf(rev); }
        for (int m = gw; m < M; m += NGW) rms_row_to_bf16(x + (size_t)m * D, g_pre_mix, XN + (size_t)m * D, lane);
    }
    SEAM(0);
    if (IN(1)) {
        pg8::Gemm g{XN, Win_t, M, NQKV, D}; pg8::StaticOrder S; S.init(M, NQKV, G, bx);
        pg8::EpiQKV E{QKV, ROPE, C2};
        pg8::gemm_phase<pg8::EpiQKV, pg8::StaticOrder, true, true>(lds, g, S, E);
    }
#if DUP_P1 > 1
    if (IN(1)) {
        pg8::Gemm g{XN, Win_t, M, NQKV, D}; pg8::StaticOrder S; S.init(M, NQKV, G, bx);
        pg8::EpiQKV E{QKV, ROPE, C2};
        pg8::gemm_phase<pg8::EpiQKV, pg8::StaticOrder, true, true>(lds, g, S, E);
    }
#endif
    SEAM(1);
    if (IN(2)) {
        const int vcu = (G % 8 == 0) ? (bx % 8) * (G / 8) + bx / 8 : bx;
        for (int p = vcu; p < 256; p += G) { const int bh = p >> 2, s = p & 3, b = bh >> 3, h = bh & 7;
            for (int k = 0; k < 2; ++k) { const int qb = k ? 7 - s : s;
                att::attn_unit<0>(lds, QKV, b * SEQ, 1, 0, 1 << 20, 4 * qb + 4, 256 * qb + 192, -64, 0, 256 * qb + 32 * wave, h * HD, 1024 + h * HD, 2048 + h * HD, MIXED, D, h * HD, g_sb, nullptr); } }
        for (int p = vcu; p < 256; p += G) { const int bh = p >> 2, b = bh >> 3, h = bh & 7;
            for (int k = 0; k < 6; ++k) { const int u = (k >> 1) * 8 + (p & 3) * 2 + (k & 1); const int qc = 3072 + h * HD, kc = 4096 + h * HD, vc = 5120 + h * HD;
                if (u < 8) { const int np = u; const int ks0 = np == 0 ? 0 : 256 * np - 128; const int nt = np == 0 ? 4 : 6;
                    att::attn_unit<1>(lds, QKV, b * SEQ, 1, 0, 1 << 20, nt, ks0, 64, 0, 256 * np + 32 * wave, qc, kc, vc, OB0, 1024, h * HD, nullptr, LSE); }
                else if (u < 16) { const int res = (u - 8) >> 1, np = (u - 8) & 1; const int ks0 = np == 0 ? 0 : 128; const int nt = np == 0 ? 4 : 6;
                    att::attn_unit<1>(lds, QKV, b * SEQ, 4, res, 1 << 20, nt, ks0, 64, res, 256 * np + 32 * wave, qc, kc, vc, OB1, 1024, h * HD, nullptr, LSE + (size_t)M * 8); }
                else { const int rp = u - 16;
                    att::attn_unit<1>(lds, QKV, b * SEQ, 16, 2 * rp, 2, 4, 0, 64, 2 * rp + (wave >> 2), 32 * (wave & 3), qc, kc, vc, OB2, 1024, h * HD, nullptr, LSE + (size_t)2 * M * 8); }
            } }
    }
    SEAM(2);
    if (IN(3)) {
        for (int m = gw; m < M; m += NGW) { const int hh = lane >> 3;
            const float l0 = LSE[(size_t)m * 8 + hh], l1 = LSE[(size_t)(M + m) * 8 + hh], l2 = LSE[(size_t)(2 * M + m) * 8 + hh];
            const float mx = fmaxf(l0, fmaxf(l1, l2)); float w0 = __builtin_amdgcn_exp2f(l0 - mx), w1 = __builtin_amdgcn_exp2f(l1 - mx), w2 = __builtin_amdgcn_exp2f(l2 - mx);
            const float wi = 1.f / (w0 + w1 + w2); w0 *= wi; w1 *= wi; w2 *= wi;
            float v[16]; float ss = 0.f;
#pragma unroll
            for (int c = 0; c < 2; ++c) { const size_t off = (size_t)m * 1024 + lane * 16 + c * 8;
                const u32x4 a0 = ldntu4((const u32x4*)(OB0 + off)), a1 = ldntu4((const u32x4*)(OB1 + off)), a2 = ldntu4((const u32x4*)(OB2 + off));
#pragma unroll
                for (int j = 0; j < 4; ++j) { v[c * 8 + 2 * j] = w0 * bf_lo(a0[j]) + w1 * bf_lo(a1[j]) + w2 * bf_lo(a2[j]); v[c * 8 + 2 * j + 1] = w0 * bf_hi(a0[j]) + w1 * bf_hi(a1[j]) + w2 * bf_hi(a2[j]); } }
#pragma unroll
            for (int j = 0; j < 16; ++j) ss += v[j] * v[j];
            ss += __shfl_xor(ss, 1); ss += __shfl_xor(ss, 2); ss += __shfl_xor(ss, 4);
            const float rstd = 1.f / sqrtf(ss * (1.f / HD) + RMS_EPS);
#pragma unroll
            for (int c = 0; c < 2; ++c) { const f32x4 ga = *(const f32x4*)(g_dil + lane * 16 + c * 8), gb = *(const f32x4*)(g_dil + lane * 16 + c * 8 + 4);
                u32x4 w; w.x = pk2(v[c * 8] * rstd * ga[0], v[c * 8 + 1] * rstd * ga[1]); w.y = pk2(v[c * 8 + 2] * rstd * ga[2], v[c * 8 + 3] * rstd * ga[3]);
                w.z = pk2(v[c * 8 + 4] * rstd * gb[0], v[c * 8 + 5] * rstd * gb[1]); w.w = pk2(v[c * 8 + 6] * rstd * gb[2], v[c * 8 + 7] * rstd * gb[3]);
                *(u32x4*)(MIXED + (size_t)m * D + 1024 + lane * 16 + c * 8) = w; } }
    }
    SEAM(3);
    if (IN(4)) {
        pg8::Gemm g{MIXED, Wout_t, M, D, D}; pg8::StaticOrder S; S.init(M, D, G, bx);
        pg8::EpiBf16 E{MIXOUT, D};
        pg8::gemm_phase<pg8::EpiBf16, pg8::StaticOrder, true, true>(lds, g, S, E);
    }
    SEAM(4);
    if (IN(5)) {
        for (int m = gw; m < M; m += NGW) {
            const u32x2* mr = (const u32x2*)(MIXOUT + (size_t)m * D) + lane; const f32x4* xr = (const f32x4*)(x + (size_t)m * D) + lane;
            f32x4 v[8]; float s = 0.f;
#pragma unroll
            for (int j = 0; j < 8; ++j) { const u32x2 w = ldntu2(mr + 64 * j); v[j] = (f32x4){bf_lo(w.x), bf_hi(w.x), bf_lo(w.y), bf_hi(w.y)}; s += (v[j][0] * v[j][0] + v[j][1] * v[j][1]) + (v[j][2] * v[j][2] + v[j][3] * v[j][3]); }
            const float rstd = 1.f / sqrtf(wave_sum(s) * (1.f / D) + RMS_EPS);
            float s2 = 0.f; if (lane == 0) RSTD1[m] = rstd;
#pragma unroll
            for (int j = 0; j < 8; ++j) { const f32x4 g = ((const f32x4*)g_post_mix)[lane + 64 * j]; const f32x4 xv = ldnt4(xr + 64 * j);
                v[j] = xv + v[j] * rstd * g; s2 += (v[j][0] * v[j][0] + v[j][1] * v[j][1]) + (v[j][2] * v[j][2] + v[j][3] * v[j][3]); }
            const float rstd2 = 1.f / sqrtf(wave_sum(s2) * (1.f / D) + RMS_EPS);
            u32x2* o8 = (u32x2*)(XN + (size_t)m * D) + lane;
#pragma unroll
            for (int j = 0; j < 8; ++j) { const f32x4 g = ((const f32x4*)g_pre_ffn)[lane + 64 * j]; u32x2 w; w.x = pk2(v[j][0] * rstd2 * g[0], v[j][1] * rstd2 * g[1]); w.y = pk2(v[j][2] * rstd2 * g[2], v[j][3] * rstd2 * g[3]); o8[64 * j] = w; }
        }
    }
    SEAM(5);
    if (IN(6)) {
        pg8::Gemm g{XN, Wup_t, M, NUP, D}; pg8::StaticOrder S; S.init(M, NUP, G, bx);
        pg8::EpiConv E{Y, conv_w, conv_b, HALO, FLAGS, lds + XCH_OFF, NUP / 256};
        pg8::gemm_phase<pg8::EpiConv, pg8::StaticOrder, true, true>(lds, g, S, E);
        { const int nun = (M / 256) * (NUP / 256); const int rem = nun % G; const int first = rem, nw = (G - first) * NWAVES;
          if (bx >= first) { LAS float* scr = (LAS float*)(lds + wave * 16384); constexpr int I_DN2 = (DFF / 64) * (D / 32);
              for (int it = (bx - first) * NWAVES + wave; it < I_DN2; it += nw) p0_transpose_item<0>(w_down, DFF, D, Wdown_t, scr, it, lane); } }
    }
#if DUP_P6 > 1
    if (IN(6)) {
        pg8::Gemm g{XN, Wup_t, M, NUP, D}; pg8::StaticOrder S; S.init(M, NUP, G, bx);
        pg8::EpiConv E{Y, conv_w, conv_b, HALO, FLAGS, lds + XCH_OFF, NUP / 256};
        pg8::gemm_phase<pg8::EpiConv, pg8::StaticOrder, true, true>(lds, g, S, E);
    }
#endif
    SEAM(6);
    if (IN(7)) {
        pg8::Gemm g{Y, Wdown_t, M, D, DFF}; pg8::StaticOrder S; S.init(M, D, G, bx);
        pg8::EpiBf16 E{F, D};
        pg8::gemm_phase<pg8::EpiBf16, pg8::StaticOrder, true, true>(lds, g, S, E);
    }
    SEAM(7);
    if (IN(8)) {
        for (int m = gw; m < M; m += NGW) {
            const u32x2* fr_ = (const u32x2*)(F + (size_t)m * D) + lane; f32x4* orow = (f32x4*)(out + (size_t)m * D) + lane;
            f32x4 v[8]; float s = 0.f;
#pragma unroll
            for (int j = 0; j < 8; ++j) { const u32x2 w = ldntu2(fr_ + 64 * j); v[j] = (f32x4){bf_lo(w.x), bf_hi(w.x), bf_lo(w.y), bf_hi(w.y)}; s += (v[j][0] * v[j][0] + v[j][1] * v[j][1]) + (v[j][2] * v[j][2] + v[j][3] * v[j][3]); }
            const float rstd = 1.f / sqrtf(wave_sum(s) * (1.f / D) + RMS_EPS);
            const float rstd1 = RSTD1[m]; const u32x2* mr = (const u32x2*)(MIXOUT + (size_t)m * D) + lane; const f32x4* xr = (const f32x4*)(x + (size_t)m * D) + lane;
#pragma unroll
            for (int j = 0; j < 8; ++j) { const f32x4 g = ((const f32x4*)g_post_ffn)[lane + 64 * j]; const f32x4 g1 = ((const f32x4*)g_post_mix)[lane + 64 * j];
                const u32x2 w = ldntu2(mr + 64 * j); const f32x4 mo = (f32x4){bf_lo(w.x), bf_hi(w.x), bf_lo(w.y), bf_hi(w.y)};
                const f32x4 x1 = ldnt4(xr + 64 * j) + mo * rstd1 * g1;
                stnt4(orow + 64 * j, x1 + v[j] * rstd * g); }
        }
    }
#undef IN
#undef SEAM
}

extern "C" void kernel_launch(void* const* d_in, const int* in_sizes, int n_in, void* d_out, int out_size, void* d_ws, size_t ws_size, hipStream_t stream) {
    static int grid = 0;
    if (grid == 0) {
        if (n_in != 13 || in_sizes[0] != M * D || out_size != M * D || ws_size < WS_END) { fprintf(stderr, "kernel_launch: unexpected shapes (n_in %d, in0 %d, out %d, ws %zu)\n", n_in, n_in > 0 ? in_sizes[0] : -1, out_size, ws_size); grid = -1; return; }
        int dev = 0, cus = 0, per_cu = 0;
        hipGetDevice(&dev); hipDeviceGetAttribute(&cus, hipDeviceAttributeMultiprocessorCount, dev);
        if (hipFuncSetAttribute((const void*)fwd_kernel, hipFuncAttributeMaxDynamicSharedMemorySize, LDS_BYTES) != hipSuccess) { fprintf(stderr, "kernel_launch: hipFuncSetAttribute failed\n"); grid = -1; return; }
        if (hipOccupancyMaxActiveBlocksPerMultiprocessor(&per_cu, (const void*)fwd_kernel, NTHREADS, LDS_BYTES) != hipSuccess || per_cu < 1) { fprintf(stderr, "kernel_launch: occupancy query says %d\n", per_cu); per_cu = 1; }
        (void)hipGetLastError();
        grid = cus * (per_cu > 1 ? 1 : per_cu);
        if (grid <= 0) grid = 256;
    }
    if (grid < 0) return;
    if (hipMemsetAsync(d_ws, 0, 131072, stream) != hipSuccess) { fprintf(stderr, "kernel_launch: memset failed\n"); return; }
    Args a{};
    for (int i = 0; i < 13; ++i) a.in[i] = (const float*)d_in[i];
    a.out = (float*)d_out; a.ws = (unsigned char*)d_ws;
#if ONE_LAUNCH
    a.ph_lo = 0; a.ph_hi = N_PHASES;
    void* kargs[] = {&a};
    hipError_t e = hipLaunchCooperativeKernel((const void*)fwd_kernel, dim3(grid), dim3(NTHREADS), kargs, LDS_BYTES, stream);
    if (e != hipSuccess) fprintf(stderr, "kernel_launch: cooperative launch failed: %s (grid %d)\n", hipGetErrorString(e), grid);
#else
    for (int ph = 0; ph < N_PHASES; ++ph) { a.ph_lo = ph; a.ph_hi = ph + 1; hipLaunchKernelGGL(fwd_kernel, dim3(grid), dim3(NTHREADS), LDS_BYTES, stream, a); }
#endif
}
```

```cpp
#include <hip/hip_runtime.h>
#include <hip/hip_cooperative_groups.h>
#include <cstdio>
#include <cstdint>
namespace cg = cooperative_groups;
#ifndef ONE_LAUNCH
#define ONE_LAUNCH 1
#endif
namespace pg8 {
#define PG8_LAS __attribute__((address_space(3)))
typedef unsigned short bf16_t;
typedef short bf16x8 __attribute__((ext_vector_type(8)));
typedef float f32x4 __attribute__((ext_vector_type(4)));
typedef unsigned u32x4 __attribute__((ext_vector_type(4)));
constexpr int BM = 256, BK = 64, HALF = 128, HTB = HALF * BK * 2  , STAGE_BYTES = 8 * HTB, NXCD = 8, WGM = 2;

__host__ __device__ __forceinline__ int lds_byte(int r, int c) { const int st = (r >> 4) * 2 + (c >> 5), rr = r & 15, cc = c & 31, ob = rr * 64 + cc * 2; return st * 1024 + (ob ^ (((ob >> 9) & 1) << 5)); }
__host__ __device__ __forceinline__ void stage_rc(int b, int& R, int& C) { const int st = b / 1024, sb = b % 1024, swz = sb ^ (((sb >> 9) & 1) << 5); R = (st >> 1) * 16 + swz / 64; C = (st & 1) * 32 + (swz % 64) / 2; }
__host__ __device__ __forceinline__ int perm32(int rho) { const int n = rho >> 4, i = rho & 15; return 8 * (i >> 2) + 4 * n + (i & 3); }

struct Unit { int pm, pn; };
struct Gemm { const bf16_t* A; const bf16_t* Bt; int M, N, K; };

struct StaticOrder {
    int nM, nN, nwg, G, c;
    __host__ __device__ void init(int M, int N, int G_, int c_) { nM = M / BM; nN = N / BM; nwg = nM * nN; G = G_; c = c_; }
    __host__ __device__ bool next(int i, Unit& u) const {
        const long L = (long)i * G + c; if (L >= nwg) return false;
        int wgid = (int)L; { const int q = nwg / NXCD, r = nwg % NXCD, xcd = wgid % NXCD, off = wgid / NXCD; wgid = (xcd < r ? xcd * (q + 1) : r * (q + 1) + (xcd - r) * q) + off; }
        const int nig = WGM * nN, gid = wgid / nig, fm = gid * WGM, gsz = (nM - fm) < WGM ? (nM - fm) : WGM;
        u.pm = fm + ((wgid % nig) % gsz); u.pn = (wgid % nig) / gsz; return true;
    }
    __device__ __forceinline__ void a_ready(const Unit&) const {}
    __device__ __forceinline__ void done(const Unit&) const {}
};

__device__ __forceinline__ unsigned cvt_pk_bf16(float lo, float hi) { unsigned r; asm volatile("v_cvt_pk_bf16_f32 %0, %1, %2" : "=v"(r) : "v"(lo), "v"(hi)); return r; }
struct EpiBf16 {
    static constexpr bool PERM = true, AFTER_DRAIN = false;
    bf16_t* O; int ldc;
    __device__ __forceinline__ void operator()(const f32x4 (&acc)[2][2][4][2], const Unit& u, int wr, int wc, int fr, int fq) const {
        const int row0 = u.pm * BM + wr * 64 + fr; const int col0 = u.pn * BM + wc * 32 + 8 * fq;
#pragma unroll
        for (int ai = 0; ai < 2; ++ai)
#pragma unroll
            for (int m = 0; m < 4; ++m) { bf16_t* rowp = O + (size_t)(row0 + ai * HALF + m * 16) * ldc + col0;
#pragma unroll
                for (int bj = 0; bj < 2; ++bj) { const f32x4 v0 = acc[ai][bj][m][0], v1 = acc[ai][bj][m][1];
                    u32x4 w; w.x = cvt_pk_bf16(v0[0], v0[1]); w.y = cvt_pk_bf16(v0[2], v0[3]); w.z = cvt_pk_bf16(v1[0], v1[1]); w.w = cvt_pk_bf16(v1[2], v1[3]);
                    *(u32x4*)(rowp + bj * HALF) = w; } }
    }
};
struct EpiQKV {
    static constexpr bool PERM = true, AFTER_DRAIN = false;
    bf16_t* O; const float* rope; float c2;
    __device__ __forceinline__ void operator()(const f32x4 (&acc)[2][2][4][2], const Unit& u, int wr, int wc, int fr, int fq) const {
        const int row0 = u.pm * BM + wr * 64 + fr; const int col0 = u.pn * BM + wc * 32 + 8 * fq;
        const int seg = u.pn >> 2; const float sc = (seg == 0 || seg == 3) ? c2 : 1.f; const bool rot = (seg == 3 || seg == 4);
#pragma unroll
        for (int ai = 0; ai < 2; ++ai)
#pragma unroll
            for (int m = 0; m < 4; ++m) { const int row = row0 + ai * HALF + m * 16; bf16_t* rowp = O + (size_t)row * 6144 + col0; const int pos = row & 2047;
#pragma unroll
                for (int bj = 0; bj < 2; ++bj) { f32x4 v0 = acc[ai][bj][m][0], v1 = acc[ai][bj][m][1];
                    if (rot) { const int dp = ((col0 + bj * HALF) & 127) >> 1; const f32x4* tp = (const f32x4*)(rope + ((size_t)pos * 64 + dp) * 2);
                        const f32x4 t0 = tp[0], t1 = tp[1];
                        v0 = (f32x4){v0[0] * t0[0] - v0[1] * t0[1], v0[1] * t0[0] + v0[0] * t0[1], v0[2] * t0[2] - v0[3] * t0[3], v0[3] * t0[2] + v0[2] * t0[3]};
                        v1 = (f32x4){v1[0] * t1[0] - v1[1] * t1[1], v1[1] * t1[0] + v1[0] * t1[1], v1[2] * t1[2] - v1[3] * t1[3], v1[3] * t1[2] + v1[2] * t1[3]}; }
                    v0 = v0 * sc; v1 = v1 * sc;
                    u32x4 w; w.x = cvt_pk_bf16(v0[0], v0[1]); w.y = cvt_pk_bf16(v0[2], v0[3]); w.z = cvt_pk_bf16(v1[0], v1[1]); w.w = cvt_pk_bf16(v1[2], v1[3]);
                    *(u32x4*)(rowp + bj * HALF) = w; } }
    }
};

typedef unsigned u32x2 __attribute__((ext_vector_type(2)));

template <int CTRL> __device__ __forceinline__ float dppf(float x) { return __builtin_bit_cast(float, __builtin_amdgcn_update_dpp(0, __builtin_bit_cast(int, x), CTRL, 0xf, 0xf, false)); }
template <int CTRL> __device__ __forceinline__ f32x4 dpp4(f32x4 v) { return (f32x4){dppf<CTRL>(v[0]), dppf<CTRL>(v[1]), dppf<CTRL>(v[2]), dppf<CTRL>(v[3])}; }
__device__ __forceinline__ float gelu_tanh_f(float x) { const float t = x * (1.f + 0.044715f * x * x) * 2.3022081983f; return x * __builtin_amdgcn_rcpf(1.f + __builtin_amdgcn_exp2f(-t)); }
__device__ __forceinline__ f32x4 ldh(const float* p) {
    const unsigned long long a = __hip_atomic_load((const unsigned long long*)p, __ATOMIC_RELAXED, __HIP_MEMORY_SCOPE_AGENT), b = __hip_atomic_load((const unsigned long long*)p + 1, __ATOMIC_RELAXED, __HIP_MEMORY_SCOPE_AGENT);
    return (f32x4){__builtin_bit_cast(float, (unsigned)a), __builtin_bit_cast(float, (unsigned)(a >> 32)), __builtin_bit_cast(float, (unsigned)b), __builtin_bit_cast(float, (unsigned)(b >> 32))}; }
template <int CTRL> __device__ __forceinline__ float dppo(float old, float x) { return __builtin_bit_cast(float, __builtin_amdgcn_update_dpp(__builtin_bit_cast(int, old), __builtin_bit_cast(int, x), CTRL, 0xf, 0xf, false)); }
template <int CTRL> __device__ __forceinline__ f32x4 dppo4(f32x4 o, f32x4 v) { return (f32x4){dppo<CTRL>(o[0], v[0]), dppo<CTRL>(o[1], v[1]), dppo<CTRL>(o[2], v[2]), dppo<CTRL>(o[3], v[3])}; }
struct EpiConv {
    static constexpr bool PERM = true, AFTER_DRAIN = false;
    bf16_t* Y; const float* cw; const float* cb; float* halo; unsigned* flags; PG8_LAS unsigned char* xch; int nN;
    __device__ __forceinline__ void operator()(const f32x4 (&acc)[2][2][4][2], const Unit& u, int wr, int wc, int fr, int fq) const {
        constexpr int NUPc = 11008, DFFc = 5504;
        const int lane = fq * 16 + fr;
        const bool need_prev = (u.pm & 7) != 0;
        if (fr >= 14) {
#pragma unroll
            for (int ai = 0; ai < 2; ++ai)
#pragma unroll
                for (int bj = 0; bj < 2; ++bj)
#pragma unroll
                    for (int n = 0; n < 2; ++n) *(PG8_LAS f32x4*)(xch + ((((ai * 2 + wr) * 4 + wc) * 2 + (fr - 14)) * 64 + bj * 32 + 8 * fq + 4 * n) * 4) = acc[ai][bj][3][n];
            if (wr == 1) { float* hp = halo + ((size_t)(u.pm * nN + u.pn) * 2 + (fr - 14)) * 256 + wc * 32 + 8 * fq;
#pragma unroll
                for (int bj = 0; bj < 2; ++bj)
#pragma unroll
                    for (int n = 0; n < 2; ++n) { const f32x4 v = acc[1][bj][3][n]; unsigned long long* q = (unsigned long long*)(hp + bj * 128 + 4 * n);
                        const float e0 = v[0], e1 = v[1], e2 = v[2], e3 = v[3];
                        __hip_atomic_store(q, ((unsigned long long)__float_as_uint(e1) << 32) | __float_as_uint(e0), __ATOMIC_RELAXED, __HIP_MEMORY_SCOPE_AGENT);
                        __hip_atomic_store(q + 1, ((unsigned long long)__float_as_uint(e3) << 32) | __float_as_uint(e2), __ATOMIC_RELAXED, __HIP_MEMORY_SCOPE_AGENT); } }
        }
        if (wr == 1) { asm volatile("s_waitcnt vmcnt(0)" ::: "memory"); if (lane == 0) __hip_atomic_fetch_add(flags + u.pm * nN + u.pn, 1u, __ATOMIC_RELAXED, __HIP_MEMORY_SCOPE_AGENT); }
        if (need_prev && wr == 0 && wc == 0) {
            const unsigned* fp = flags + (u.pm - 1) * nN + u.pn;
            for (unsigned sp_ = 0; (unsigned)__builtin_amdgcn_readfirstlane(__hip_atomic_load(fp, __ATOMIC_RELAXED, __HIP_MEMORY_SCOPE_AGENT)) < 4u && sp_ < (1u << 22); ++sp_) __builtin_amdgcn_s_sleep(2);
            __builtin_amdgcn_fence(__ATOMIC_ACQUIRE, "agent");
            asm volatile("s_waitcnt vmcnt(0)" ::: "memory");
        }
        asm volatile("s_waitcnt lgkmcnt(0)" ::: "memory"); __builtin_amdgcn_s_barrier(); asm volatile("" ::: "memory");
        u32x2 ypk[2][4];
#pragma unroll
        for (int n = 0; n < 2; ++n) {
            const int fcol = u.pn * 128 + wc * 32 + 8 * fq + 4 * n;
            f32x4 wg[3], wv[3];
#pragma unroll
            for (int j = 0; j < 3; ++j) { wg[j] = *(const f32x4*)(cw + (size_t)j * NUPc + fcol); wv[j] = *(const f32x4*)(cw + (size_t)j * NUPc + DFFc + fcol); }
            const f32x4 bg = *(const f32x4*)(cb + fcol), bv = *(const f32x4*)(cb + DFFc + fcol);
#pragma unroll
            for (int ai = 0; ai < 2; ++ai) {
                f32x4 h1g, h2g, h1v, h2v;
                const int ci = 2 * ai + wr;
                if (ci == 0) {
                    if (need_prev) { const float* hp = halo + ((size_t)((u.pm - 1) * nN + u.pn) * 2) * 256 + wc * 32 + 8 * fq + 4 * n;
                        h2g = ldh(hp); h2v = ldh(hp + 128); h1g = ldh(hp + 256); h1v = ldh(hp + 256 + 128); }
                    else { h1g = h2g = h1v = h2v = (f32x4){0.f, 0.f, 0.f, 0.f}; }
                } else { const int cp = ci - 1; const PG8_LAS unsigned char* xp = xch + ((((cp >> 1) * 2 + (cp & 1)) * 4 + wc) * 2 * 64 + 8 * fq + 4 * n) * 4;
                    h2g = *(const PG8_LAS f32x4*)(xp); h2v = *(const PG8_LAS f32x4*)(xp + 32 * 4); h1g = *(const PG8_LAS f32x4*)(xp + 64 * 4); h1v = *(const PG8_LAS f32x4*)(xp + 64 * 4 + 32 * 4); }
                f32x4 og1 = h1g, ov1 = h1v, og2, ov2;
#pragma unroll
                for (int e = 0; e < 4; ++e) { og2[e] = fr == 1 ? h1g[e] : h2g[e]; ov2[e] = fr == 1 ? h1v[e] : h2v[e]; }
#pragma unroll
                for (int m = 0; m < 4; ++m) {
                    const f32x4 g0 = acc[ai][0][m][n], v0 = acc[ai][1][m][n];
                    const f32x4 g1 = dppo4<0x111>(og1, g0), g2 = dppo4<0x112>(og2, g0), v1 = dppo4<0x111>(ov1, v0), v2 = dppo4<0x112>(ov2, v0);
                    if (m < 3) { og1 = dpp4<0x121>(g0); og2 = dpp4<0x122>(g0); ov1 = dpp4<0x121>(v0); ov2 = dpp4<0x122>(v0); }
                    const f32x4 gt = bg + wg[0] * g2 + wg[1] * g1 + wg[2] * g0, vl = bv + wv[0] * v2 + wv[1] * v1 + wv[2] * v0;
                    u32x2 w; w.x = cvt_pk_bf16(gelu_tanh_f(gt[0]) * vl[0], gelu_tanh_f(gt[1]) * vl[1]); w.y = cvt_pk_bf16(gelu_tanh_f(gt[2]) * vl[2], gelu_tanh_f(gt[3]) * vl[3]);
                    if (n == 0) ypk[ai][m] = w;
                    else { u32x4 o; o.x = ypk[ai][m].x; o.y = ypk[ai][m].y; o.z = w.x; o.w = w.y;
                        *(u32x4*)(Y + (size_t)(u.pm * BM + ai * HALF + wr * 64 + m * 16 + fr) * DFFc + u.pn * 128 + wc * 32 + 8 * fq) = o; }
                }
            }
        }
    }
};
template <class Epi, class Sched, bool ALIGN_EPI = false, bool SP2 = false>
__device__ __forceinline__ void gemm_phase(PG8_LAS unsigned char* lds, const Gemm g, const Sched& S, const Epi& E) {
    const int tid = threadIdx.x, wid = __builtin_amdgcn_readfirstlane(tid >> 6), lane = tid & 63, wr = wid >> 2, wc = wid & 3, fr = lane & 15, fq = lane >> 4;
    const int K = g.K, nt = K / BK;
    unsigned voffA[2], voffB[2];
#pragma unroll
    for (int i = 0; i < 2; ++i) { int R, C; stage_rc(tid * 16 + i * 8192, R, C); const int Rb = Epi::PERM ? ((R & ~31) + perm32(R & 31)) : R;
        voffA[i] = (unsigned)(R * K + C) * 2u; voffB[i] = (unsigned)(Rb * K + C) * 2u; }
    const size_t kstep = (size_t)(BK * 2);
    const size_t hstep = (size_t)HALF * K * 2;
    const size_t tstep = 2 * hstep;
    const unsigned ldsw = (unsigned)wid * 1024u;
    const int aoff = lds_byte(wr * 64 + fr, fq * 8), boff = lds_byte(wc * 32 + fr, fq * 8);
#define PG8_SA(b, h) (((b) * 2 + (h)) * HTB)
#define PG8_SB(b, h) ((4 + (b) * 2 + (h)) * HTB)
#define PG8_STAGE(bufoff, gbase, voff) do { _Pragma("unroll") for (int _i = 0; _i < 2; ++_i) \
        __builtin_amdgcn_global_load_lds((const unsigned*)((const char*)(gbase) + (voff)[_i]), (PG8_LAS unsigned*)(lds + (bufoff) + ldsw + _i * 8192), 16, 0, 0); } while (0)
#define PG8_LDA(dst, b, h) do { _Pragma("unroll") for (int m = 0; m < 4; ++m) _Pragma("unroll") for (int k = 0; k < 2; ++k) dst[m][k] = *(const PG8_LAS bf16x8*)(lds + PG8_SA(b, h) + aoff + m * 2048 + k * 1024); } while (0)
#define PG8_LDB(dst, b, h) do { _Pragma("unroll") for (int n = 0; n < 2; ++n) _Pragma("unroll") for (int k = 0; k < 2; ++k) dst[n][k] = *(const PG8_LAS bf16x8*)(lds + PG8_SB(b, h) + boff + n * 2048 + k * 1024); } while (0)
#define PG8_MMA(ai, bj, At, Bt) do { __builtin_amdgcn_s_setprio(1); _Pragma("unroll") for (int m = 0; m < 4; ++m) _Pragma("unroll") for (int n = 0; n < 2; ++n) _Pragma("unroll") for (int k = 0; k < 2; ++k) \
        acc[ai][bj][m][n] = __builtin_amdgcn_mfma_f32_16x16x32_bf16(Bt[n][k], At[m][k], acc[ai][bj][m][n], 0, 0, 0); __builtin_amdgcn_s_setprio(0); } while (0)
#define PG8_WAIT_V(n) asm volatile("s_waitcnt vmcnt(" #n ")" ::: "memory")
#define PG8_WAIT_L(n) asm volatile("s_waitcnt lgkmcnt(" #n ")" ::: "memory")
#define PG8_BAR __builtin_amdgcn_s_barrier()
#define PG8_SCHED __builtin_amdgcn_sched_barrier(0)
    Unit cur, nxt; int ui = 0;
    if (!S.next(0, cur)) return;
    f32x4 acc[2][2][4][2];
#pragma unroll
    for (int a = 0; a < 2; ++a)
#pragma unroll
        for (int b = 0; b < 2; ++b)
#pragma unroll
            for (int m = 0; m < 4; ++m)
#pragma unroll
                for (int n = 0; n < 2; ++n) acc[a][b][m][n] = (f32x4){0.f, 0.f, 0.f, 0.f};
    bf16x8 At[4][2], B0[2][2], B1[2][2];
    const char* cA = (const char*)g.A + (size_t)cur.pm * tstep; const char* cB = (const char*)g.Bt + (size_t)cur.pn * tstep;
    S.a_ready(cur);
    if constexpr (SP2) {
        PG8_STAGE(PG8_SB(0, 0), cB, voffB); PG8_STAGE(PG8_SB(0, 1), cB + hstep, voffB); PG8_STAGE(PG8_SA(0, 0), cA, voffA); PG8_STAGE(PG8_SA(0, 1), cA + hstep, voffA);
        if (wr == 1) PG8_BAR;
        PG8_WAIT_V(2); PG8_BAR;
        PG8_STAGE(PG8_SB(1, 0), cB + kstep, voffB); PG8_STAGE(PG8_SA(1, 0), cA + kstep, voffA); PG8_STAGE(PG8_SB(1, 1), cB + hstep + kstep, voffB);
        PG8_WAIT_V(6); PG8_BAR;
    } else {
        PG8_STAGE(PG8_SB(0, 0), cB, voffB); PG8_STAGE(PG8_SA(0, 0), cA, voffA); PG8_STAGE(PG8_SB(0, 1), cB + hstep, voffB); PG8_STAGE(PG8_SA(0, 1), cA + hstep, voffA);
        if (wr == 1) PG8_BAR;
        PG8_WAIT_V(4); PG8_BAR;
        PG8_STAGE(PG8_SB(1, 0), cB + kstep, voffB); PG8_STAGE(PG8_SA(1, 0), cA + kstep, voffA); PG8_STAGE(PG8_SB(1, 1), cB + hstep + kstep, voffB);
        PG8_WAIT_V(6); PG8_BAR;
    }
    for (;;) {
        const bool has_next = S.next(ui + 1, nxt);
        const char* nA = has_next ? (const char*)g.A + (size_t)nxt.pm * tstep : cA; const char* nB = has_next ? (const char*)g.Bt + (size_t)nxt.pn * tstep : cB;
        for (int t = 0; t < nt; t += 2) {
            const bool last = (t == nt - 2);
            const char* a1 = cA + (size_t)(t + 1) * kstep;
            const char* a2 = last ? nA : cA + (size_t)(t + 2) * kstep; const char* b2 = last ? nB : cB + (size_t)(t + 2) * kstep;
            const char* a3 = a2 + kstep; const char* b3 = b2 + kstep;
            if (last && has_next) S.a_ready(nxt);
            if constexpr (SP2) {
            PG8_LDB(B0, 0, 0); PG8_LDB(B1, 0, 1); PG8_SCHED; PG8_LDA(At, 0, 0); PG8_STAGE(PG8_SA(1, 1), a1 + hstep, voffA);
            PG8_WAIT_V(8); PG8_WAIT_L(0); PG8_BAR; PG8_MMA(0, 0, At, B0); PG8_MMA(0, 1, At, B1); PG8_BAR; PG8_SCHED;
            PG8_LDA(At, 0, 1); PG8_STAGE(PG8_SB(0, 0), b2, voffB); PG8_STAGE(PG8_SB(0, 1), b2 + hstep, voffB); PG8_STAGE(PG8_SA(0, 0), a2, voffA);
            PG8_WAIT_V(8); PG8_WAIT_L(0); PG8_BAR; PG8_MMA(1, 0, At, B0); PG8_MMA(1, 1, At, B1); PG8_BAR; PG8_SCHED;
            PG8_LDB(B0, 1, 0); PG8_LDB(B1, 1, 1); PG8_SCHED; PG8_LDA(At, 1, 0); PG8_STAGE(PG8_SA(0, 1), a2 + hstep, voffA);
            PG8_WAIT_V(8); PG8_WAIT_L(0); PG8_BAR; PG8_MMA(0, 0, At, B0); PG8_MMA(0, 1, At, B1); PG8_BAR; PG8_SCHED;
            PG8_LDA(At, 1, 1); PG8_STAGE(PG8_SB(1, 0), b3, voffB); PG8_STAGE(PG8_SB(1, 1), b3 + hstep, voffB); PG8_STAGE(PG8_SA(1, 0), a3, voffA);
            PG8_WAIT_V(8); PG8_WAIT_L(0); PG8_BAR; PG8_MMA(1, 0, At, B0); PG8_MMA(1, 1, At, B1); PG8_BAR; PG8_SCHED;
            } else {
            PG8_LDB(B0, 0, 0); PG8_SCHED; PG8_LDA(At, 0, 0); PG8_STAGE(PG8_SA(1, 1), a1 + hstep, voffA);
            PG8_WAIT_L(8); PG8_BAR; PG8_WAIT_L(0); PG8_MMA(0, 0, At, B0); PG8_BAR; PG8_SCHED;
            PG8_LDB(B1, 0, 1); PG8_STAGE(PG8_SB(0, 0), b2, voffB);
            PG8_BAR; PG8_WAIT_L(0); PG8_MMA(0, 1, At, B1); PG8_BAR;
            PG8_LDA(At, 0, 1); PG8_STAGE(PG8_SA(0, 0), a2, voffA);
            PG8_BAR; PG8_WAIT_L(0); PG8_MMA(1, 0, At, B0); PG8_BAR; PG8_SCHED;
            PG8_STAGE(PG8_SB(0, 1), b2 + hstep, voffB);
            PG8_WAIT_V(6); PG8_BAR; PG8_MMA(1, 1, At, B1); PG8_BAR;
            PG8_LDB(B0, 1, 0); PG8_SCHED; PG8_LDA(At, 1, 0); PG8_STAGE(PG8_SA(0, 1), a2 + hstep, voffA);
            PG8_WAIT_L(8); PG8_BAR; PG8_WAIT_L(0); PG8_MMA(0, 0, At, B0); PG8_BAR; PG8_SCHED;
            PG8_LDB(B1, 1, 1); PG8_STAGE(PG8_SB(1, 0), b3, voffB);
            PG8_BAR; PG8_WAIT_L(0); PG8_MMA(0, 1, At, B1); PG8_BAR;
            PG8_LDA(At, 1, 1); PG8_STAGE(PG8_SA(1, 0), a3, voffA);
            PG8_BAR; PG8_WAIT_L(0); PG8_MMA(1, 0, At, B0); PG8_BAR; PG8_SCHED;
            PG8_STAGE(PG8_SB(1, 1), b3 + hstep, voffB);
            PG8_WAIT_V(6); PG8_BAR; PG8_MMA(1, 1, At, B1); PG8_BAR;
            }
        }
        if constexpr (ALIGN_EPI) { if (wr == 0) PG8_BAR; }
        if constexpr (!Epi::AFTER_DRAIN) { E(acc, cur, wr, wc, fr, fq); S.done(cur); }
        if (!has_next) break;
#pragma unroll
        for (int a = 0; a < 2; ++a)
#pragma unroll
            for (int b = 0; b < 2; ++b)
#pragma unroll
                for (int m = 0; m < 4; ++m)
#pragma unroll
                    for (int n = 0; n < 2; ++n) acc[a][b][m][n] = (f32x4){0.f, 0.f, 0.f, 0.f};
        cur = nxt; cA = nA; cB = nB; ++ui;
        if constexpr (ALIGN_EPI) { if (wr == 1) PG8_BAR; }
    }
    PG8_WAIT_V(0);
    if constexpr (!ALIGN_EPI) { if (wr == 0) PG8_BAR; }
    PG8_BAR;
    if constexpr (Epi::AFTER_DRAIN) { E.fused(acc, cur, wr, wc, fr, fq, lds, wid, lane); S.done(cur); }
#undef PG8_SA
#undef PG8_SB
#undef PG8_STAGE
#undef PG8_LDA
#undef PG8_LDB
#undef PG8_MMA
#undef PG8_WAIT_V
#undef PG8_WAIT_L
#undef PG8_BAR
#undef PG8_SCHED
}
}
using pg8::bf16_t; using pg8::bf16x8; using pg8::f32x4; using pg8::u32x4;
#define LAS __attribute__((address_space(3)))
typedef float f32x16 __attribute__((ext_vector_type(16)));
using pg8::u32x2;
typedef short s16x4 __attribute__((ext_vector_type(4)));

constexpr int SEQ = 2048, BATCH = 8, M = BATCH * SEQ, D = 2048, NQKV = 6144, DFF = 5504, NUP = 2 * DFF, HD = 128;
constexpr float RMS_EPS = 1e-6f;
constexpr float C2 = 0.08838834764831845f * 1.4426950408889634f;
constexpr int NWAVES = 8, NTHREADS = 512;
constexpr int MHALF = M / 2;
constexpr size_t MiB = 1u << 20;
constexpr size_t WS_ROPE = 1 * MiB;
constexpr size_t WS_WIN = 2 * MiB, WS_WOUT = 26 * MiB, WS_WUP = 34 * MiB, WS_WDOWN = 77 * MiB;
constexpr size_t WS_XN = 100 * MiB;
constexpr size_t WS_OB2 = 100 * MiB, WS_LSE = 132 * MiB;
constexpr size_t WS_QKV = 164 * MiB;
constexpr size_t WS_MIXED = 356 * MiB;
constexpr size_t WS_MIXOUT = 420 * MiB;
constexpr size_t WS_OB0 = 420 * MiB, WS_OB1 = 452 * MiB;
constexpr size_t WS_Y = 164 * MiB;
constexpr size_t WS_HALO = 340 * MiB;
constexpr size_t WS_BAR = 65536;
constexpr size_t WS_RSTD1 = 348 * MiB;
constexpr size_t WS_FLAGS = 0;
constexpr size_t WS_END = 484 * MiB;
constexpr int RING_BYTES = 131072, XCH_OFF = RING_BYTES, LDS_BYTES = 163840, BARST_OFF = LDS_BYTES - 64;

__device__ __forceinline__ u32x4 ldntu4(const u32x4* p) { return __builtin_nontemporal_load(p); }
__device__ __forceinline__ u32x2 ldntu2(const u32x2* p) { return __builtin_nontemporal_load(p); }
__device__ __forceinline__ f32x4 ldnt4(const f32x4* p) { return __builtin_nontemporal_load(p); }
__device__ __forceinline__ void stnt4(f32x4* p, f32x4 v) { __builtin_nontemporal_store(v, p); }
__device__ __forceinline__ float wave_sum(float v) {
#pragma unroll
    for (int o = 1; o < 64; o <<= 1) v += __shfl_xor(v, o);
    return v;
}
__device__ __forceinline__ unsigned f2bf(float f) { unsigned u = __builtin_bit_cast(unsigned, f); return (u + 0x7fffu + ((u >> 16) & 1u)) >> 16; }
__device__ __forceinline__ unsigned pk2(float lo, float hi) { unsigned r; asm("v_cvt_pk_bf16_f32 %0, %1, %2" : "=v"(r) : "v"(lo), "v"(hi)); return r; }
__device__ __forceinline__ float bf_lo(unsigned w) { return __builtin_bit_cast(float, w << 16); }
__device__ __forceinline__ float bf_hi(unsigned w) { return __builtin_bit_cast(float, w & 0xffff0000u); }

__device__ __forceinline__ int win_rowmap(int n) { const int seg = n >> 10; if (seg == 3 || seg == 4) { const int w = n & 1023, hh = w >> 7, d = w & 127; return (seg << 10) + (hh << 7) + 2 * (d & 63) + (d >> 6); } return n; }
__device__ __forceinline__ int up_rowmap(int n) { const int f = n < DFF ? n : n - DFF; return (f >> 7) * 256 + (n < DFF ? 0 : 128) + (f & 127); }
template <int MAP> __device__ __forceinline__ void p0_transpose_item(const float* __restrict__ W, int K, int N, bf16_t* WT, LAS float* scr, int item, int lane) {
    const int nblk = N / 32, kb = item / nblk, nb = item % nblk, k0 = 64 * kb, n0 = 32 * nb;
#pragma unroll 8
    for (int i = 0; i < 32; ++i) { const int kk = 2 * i + (lane >> 5); scr[kk * 33 + (lane & 31)] = __builtin_nontemporal_load(W + (size_t)(k0 + kk) * N + n0 + (lane & 31)); }
    asm volatile("s_waitcnt lgkmcnt(0)" ::: "memory");
    const int c = lane & 7;
#pragma unroll
    for (int j = 0; j < 4; ++j) { const int n = (lane >> 3) + 8 * j; const LAS float* s = scr + (8 * c) * 33 + n;
        u32x4 o; o.x = pk2(s[0 * 33], s[1 * 33]); o.y = pk2(s[2 * 33], s[3 * 33]); o.z = pk2(s[4 * 33], s[5 * 33]); o.w = pk2(s[6 * 33], s[7 * 33]);
        const int drow = MAP == 1 ? win_rowmap(n0 + n) : (MAP == 2 ? up_rowmap(n0 + n) : (n0 + n));
        *(u32x4*)(WT + (size_t)drow * K + k0 + 8 * c) = o; }
    asm volatile("s_waitcnt lgkmcnt(0)" ::: "memory");
}
__device__ __forceinline__ void rms_row_to_bf16(const float* xrow, const float* gain, bf16_t* orow, int lane) {
    const f32x4* xr = (const f32x4*)xrow + lane; f32x4 v[8]; float s = 0.f;
#pragma unroll
    for (int j = 0; j < 8; ++j) { v[j] = ldnt4(xr + 64 * j); s += (v[j][0] * v[j][0] + v[j][1] * v[j][1]) + (v[j][2] * v[j][2] + v[j][3] * v[j][3]); }
    const float rstd = 1.f / sqrtf(wave_sum(s) * (1.f / D) + RMS_EPS);
    const f32x4* gr = (const f32x4*)gain + lane; u32x2* o8 = (u32x2*)orow + lane;
#pragma unroll
    for (int j = 0; j < 8; ++j) { const f32x4 g = gr[64 * j]; u32x2 w; w.x = pk2(v[j][0] * rstd * g[0], v[j][1] * rstd * g[1]); w.y = pk2(v[j][2] * rstd * g[2], v[j][3] * rstd * g[3]); o8[64 * j] = w; }
}

namespace att {
constexpr int KST = 272, VST = 320, KTB = 64 * KST, VTB = 64 * VST, BUFB = KTB + VTB;
constexpr int PITCH = NQKV;
constexpr float SB_DONE_BITS = 48.f;
__device__ __forceinline__ constexpr int crow(int r, int hi) { return (r & 3) + 8 * (r >> 2) + 4 * hi; }
struct HalfPair { float lo, up; };
__device__ __forceinline__ HalfPair xhalf(float v) { const auto rr = __builtin_amdgcn_permlane32_swap(__float_as_uint(v), __float_as_uint(v), false, false); return HalfPair{__uint_as_float(rr[0]), __uint_as_float(rr[1])}; }
__device__ __forceinline__ float xhalf_sum(float v) { const HalfPair h = xhalf(v); return h.lo + h.up; }
__device__ __forceinline__ float xhalf_max(float v) { const HalfPair h = xhalf(v); return __builtin_fmaxf(h.lo, h.up); }
__device__ __forceinline__ s16x4 vtr(const LAS unsigned char* p) { return __builtin_bit_cast(s16x4, __builtin_amdgcn_ds_read_tr16_b64_v4i16((LAS s16x4*)p)); }

template <int KIND, int VS = VST> __device__ __forceinline__ void subblock(const LAS unsigned char* kt, const LAS unsigned char* vt, const bf16x8 (&qf)[8], f32x16 (&o)[4], float& st0, float& st1, const int mask, const int r32, const int hi, const int lane) {
    f32x16 z = {0.f, 0.f, 0.f, 0.f, 0.f, 0.f, 0.f, 0.f, 0.f, 0.f, 0.f, 0.f, 0.f, 0.f, 0.f, 0.f}, z1 = z;
    const LAS unsigned char* kp = kt + r32 * KST + hi * 16;
#pragma unroll
    for (int d0 = 0; d0 < 8; d0 += 2) { const bf16x8 kf = *(const LAS bf16x8*)(kp + d0 * 32), kg = *(const LAS bf16x8*)(kp + d0 * 32 + 32);
        z = __builtin_amdgcn_mfma_f32_32x32x16_bf16(kf, qf[d0], z, 0, 0, 0); z1 = __builtin_amdgcn_mfma_f32_32x32x16_bf16(kg, qf[d0 + 1], z1, 0, 0, 0); }
    z = z + z1;
    float p[16];
    if (KIND == 0) {
        float L[16];
#pragma unroll
        for (int r = 0; r < 16; ++r) { const float zz = __builtin_fminf(z[r], 120.f); const float e = __builtin_amdgcn_exp2f(zz); float l2 = __builtin_amdgcn_logf(1.f + e);
            if (mask == 1 && !(crow(r, hi) < r32)) l2 = 0.f; L[r] = l2; }
        HalfPair gp[4];
#pragma unroll
        for (int i = 0; i < 4; ++i) gp[i] = xhalf((L[4 * i] + L[4 * i + 1]) + (L[4 * i + 2] + L[4 * i + 3]));
        float t[4]; t[3] = 0.f; t[2] = gp[3].lo + gp[3].up; t[1] = t[2] + (gp[2].lo + gp[2].up); t[0] = t[1] + (gp[1].lo + gp[1].up);
        const float T = t[0] + (gp[0].lo + gp[0].up);
#pragma unroll
        for (int i = 0; i < 4; ++i) { const float b = st0 + t[i] + (hi == 0 ? gp[i].up : 0.f);
            const float w3 = b + L[4 * i + 3], w2 = w3 + L[4 * i + 2], w1 = w2 + L[4 * i + 1], w0 = w1 + L[4 * i + 0];
            p[4 * i + 0] = z[4 * i + 0] - w0; p[4 * i + 1] = z[4 * i + 1] - w1; p[4 * i + 2] = z[4 * i + 2] - w2; p[4 * i + 3] = z[4 * i + 3] - w3; }
#pragma unroll
        for (int r = 0; r < 16; ++r) { float a = __builtin_amdgcn_exp2f(p[r]); if (mask == 1 && !(crow(r, hi) < r32)) a = 0.f; p[r] = a; }
        st0 += T;
    } else {
        float rm = -INFINITY;
#pragma unroll
        for (int r = 0; r < 16; ++r) { float zz = z[r]; if (mask == 1 && crow(r, hi) > r32) zz = -INFINITY; if (mask == 2 && crow(r, hi) < r32) zz = -INFINITY; p[r] = zz; rm = __builtin_fmaxf(rm, zz); }
        rm = xhalf_max(rm);
        if (__any(rm > st0 + 8.f)) { const float mn = __builtin_fmaxf(st0, rm); const float alpha = __builtin_amdgcn_exp2f(st0 - mn); st0 = mn; st1 *= alpha;
#pragma unroll
            for (int d0 = 0; d0 < 4; ++d0) o[d0] = o[d0] * alpha; }
        float s = 0.f;
#pragma unroll
        for (int r = 0; r < 16; ++r) { p[r] = __builtin_amdgcn_exp2f(p[r] - st0); s += p[r]; }
        st1 += s;
    }
    u32x4 pw0, pw1;
    pw0.x = pg8::cvt_pk_bf16(p[0], p[1]); pw0.y = pg8::cvt_pk_bf16(p[2], p[3]); pw0.z = pg8::cvt_pk_bf16(p[4], p[5]); pw0.w = pg8::cvt_pk_bf16(p[6], p[7]);
    pw1.x = pg8::cvt_pk_bf16(p[8], p[9]); pw1.y = pg8::cvt_pk_bf16(p[10], p[11]); pw1.z = pg8::cvt_pk_bf16(p[12], p[13]); pw1.w = pg8::cvt_pk_bf16(p[14], p[15]);
    const bf16x8 pa0 = __builtin_bit_cast(bf16x8, pw0), pa1 = __builtin_bit_cast(bf16x8, pw1);
    const LAS unsigned char* vp = vt + (4 * hi + ((lane & 15) >> 2)) * VS + ((lane >> 4) & 1) * 32 + (lane & 3) * 8;
#pragma unroll
    for (int d0 = 0; d0 < 4; ++d0) {
        const s16x4 a0 = vtr(vp + d0 * 64), a1 = vtr(vp + d0 * 64 + 8 * VS), b0 = vtr(vp + d0 * 64 + 16 * VS), b1 = vtr(vp + d0 * 64 + 24 * VS);
        const bf16x8 va = (bf16x8){a0[0], a0[1], a0[2], a0[3], a1[0], a1[1], a1[2], a1[3]}, vb = (bf16x8){b0[0], b0[1], b0[2], b0[3], b1[0], b1[1], b1[2], b1[3]};
        o[d0] = __builtin_amdgcn_mfma_f32_32x32x16_bf16(va, pa0, o[d0], 0, 0, 0);
        o[d0] = __builtin_amdgcn_mfma_f32_32x32x16_bf16(vb, pa1, o[d0], 0, 0, 0);
    }
}

template <int KIND> __device__ __forceinline__ void attn_unit(LAS unsigned char* lds, const bf16_t* __restrict__ QKV, int rb, int dil, int res0, int isplit, int nt, int ks_first, int kstep,
                                                             int res_w, int lw0, int qcol, int kcol, int vcol, bf16_t* Out, int out_pitch, int ocol, const float* gain, float* lse_out) {
    const int tid = threadIdx.x, lane = tid & 63, r32 = lane & 31, hi = lane >> 5;
    const int tq = rb + (lw0 + r32) * dil + res_w;
    bf16x8 qf[8];
    { const bf16_t* qp = QKV + (size_t)tq * PITCH + qcol + hi * 8;
#pragma unroll
      for (int d0 = 0; d0 < 8; ++d0) qf[d0] = *(const bf16x8*)(qp + d0 * 16); }
    f32x16 o[4];
#pragma unroll
    for (int d0 = 0; d0 < 4; ++d0) o[d0] = (f32x16){0.f, 0.f, 0.f, 0.f, 0.f, 0.f, 0.f, 0.f, 0.f, 0.f, 0.f, 0.f, 0.f, 0.f, 0.f, 0.f};
    float st0 = (KIND == 0) ? 0.f : -INFINITY, st1 = 0.f;
    const int srow = tid >> 4, sch = tid & 15;
    u32x4 krA[2], vrA[2], krB[2], vrB[2];
#define ATT_TILE_GEOM(i, res_i, ks_i) const int sp_ = ((i) >= isplit) ? 1 : 0; const int res_i = res0 + sp_; const int ks_i = ks_first + kstep * ((i) - (sp_ ? isplit : 0));
#define ATT_LOAD(i, KR, VR) do { ATT_TILE_GEOM(i, res_i, ks_i) _Pragma("unroll") for (int c = 0; c < 2; ++c) { const int tok = rb + (ks_i + srow + 32 * c) * dil + res_i; const bf16_t* p = QKV + (size_t)tok * PITCH + sch * 8; \
        KR[c] = *(const u32x4*)(p + kcol); VR[c] = *(const u32x4*)(p + vcol); } } while (0)
#define ATT_STORE(buf, KR, VR) do { _Pragma("unroll") for (int c = 0; c < 2; ++c) { *(LAS u32x4*)(lds + (buf) * BUFB + (srow + 32 * c) * KST + sch * 16) = KR[c]; *(LAS u32x4*)(lds + (buf) * BUFB + KTB + (srow + 32 * c) * VST + sch * 16) = VR[c]; } } while (0)
#define ATT_ITER(i, KRA, VRA, KRB, VRB) do { \
        { const int ip_ = ((i) + 2 < nt) ? (i) + 2 : nt - 1; ATT_LOAD(ip_, KRB, VRB); }     \
        { ATT_TILE_GEOM(i, res_i, ks_i) \
          if (res_i == res_w) { \
            const LAS unsigned char* kb = lds + ((i) & 1) * BUFB; const LAS unsigned char* vb = kb + KTB; \
            _Pragma("unroll") for (int ss = 0; ss < 2; ++ss) { const int sub = (KIND == 0) ? 1 - ss : ss; const int kss = ks_i + 32 * sub; \
                const bool need = (kss <= lw0) && (KIND == 0 || kss >= lw0 - 128); \
                if (need) { const int mask = (kss == lw0) ? 1 : ((KIND == 1 && kss == lw0 - 128) ? 2 : 0); \
                    subblock<KIND>(kb + sub * 32 * KST, vb + sub * 32 * VST, qf, o, st0, st1, mask, r32, hi, lane); } } \
          } } \
        if (KIND == 0) { const int dn_ = __all(st0 > SB_DONE_BITS) ? 1 : 0; if (lane == 0) dflag[((i) & 1) * 8 + wid] = dn_; } \
        ATT_STORE(((i) + 1) & 1, KRA, VRA);     \
        __syncthreads(); \
        if (KIND == 0) { const u32x4 fa_ = *(const LAS u32x4*)(dflag + ((i) & 1) * 8), fb_ = *(const LAS u32x4*)(dflag + ((i) & 1) * 8 + 4); \
            stop_ = (fa_.x & fa_.y & fa_.z & fa_.w & fb_.x & fb_.y & fb_.z & fb_.w) != 0u; } } while (0)
    ATT_LOAD(0, krA, vrA); ATT_STORE(0, krA, vrA); ATT_LOAD(1, krA, vrA); __syncthreads();
    LAS unsigned* dflag = (LAS unsigned*)(lds + 2 * BUFB); const int wid = tid >> 6; bool stop_ = false;
    for (int i = 0; i < nt; i += 2) { ATT_ITER(i, krA, vrA, krB, vrB); if (stop_) break; ATT_ITER(i + 1, krB, vrB, krA, vrA); if (stop_) break; }
    if (KIND == 0) __syncthreads();
#undef ATT_ITER
#undef ATT_LOAD
#undef ATT_STORE
#undef ATT_TILE_GEOM
    bf16_t* orow = Out + (size_t)tq * out_pitch + ocol + 4 * hi;
    if (KIND == 0) {
        float ss = 0.f;
#pragma unroll
        for (int d0 = 0; d0 < 4; ++d0)
#pragma unroll
            for (int r = 0; r < 16; ++r) ss += o[d0][r] * o[d0][r];
        ss = xhalf_sum(ss);
        const float rstd = 1.f / sqrtf(ss * (1.f / HD) + RMS_EPS);
#pragma unroll
        for (int d0 = 0; d0 < 4; ++d0)
#pragma unroll
            for (int i4 = 0; i4 < 4; ++i4) { const f32x4 g = *(const f32x4*)(gain + ocol + 32 * d0 + 8 * i4 + 4 * hi);
                u32x2 w; w.x = pk2(o[d0][4 * i4] * rstd * g[0], o[d0][4 * i4 + 1] * rstd * g[1]); w.y = pk2(o[d0][4 * i4 + 2] * rstd * g[2], o[d0][4 * i4 + 3] * rstd * g[3]);
                *(u32x2*)(orow + 32 * d0 + 8 * i4) = w; }
    } else {
        const float l = xhalf_sum(st1); const float inv = 1.f / l;
#pragma unroll
        for (int d0 = 0; d0 < 4; ++d0)
#pragma unroll
            for (int i4 = 0; i4 < 4; ++i4) { u32x2 w; w.x = pk2(o[d0][4 * i4] * inv, o[d0][4 * i4 + 1] * inv); w.y = pk2(o[d0][4 * i4 + 2] * inv, o[d0][4 * i4 + 3] * inv);
                *(u32x2*)(orow + 32 * d0 + 8 * i4) = w; }
        if (hi == 0) lse_out[(size_t)tq * 8 + (ocol >> 7)] = st0 + __builtin_amdgcn_logf(l);
    }
}

constexpr int WF_VS = 272, WF_SLOT = 32 * KST + 32 * WF_VS;
__device__ __forceinline__ void dil_wf_unit(LAS unsigned char* lds, const bf16_t* __restrict__ QKV, const int rb, const int d, const int res_base, const bool two, const int Lq0,
                                            const int qcol, const int kcol, const int vcol, bf16_t* OB, float* lse_out, const int ocol) {
    const int tid = threadIdx.x, lane = tid & 63, r32 = lane & 31, hi = lane >> 5, wave = __builtin_amdgcn_readfirstlane(tid >> 6);
    const int cls = two ? wave >> 2 : 0, wq = two ? wave & 3 : wave;
    const int res_w = res_base + cls, lw0 = Lq0 + 32 * wq;
    const int tq = rb + (lw0 + r32) * d + res_w;
    const int srow = tid >> 4, sch = tid & 15; const int koff = srow * KST + sch * 16, voff = 32 * KST + srow * WF_VS + sch * 16;
    u32x4 kr[8], vr[8], kn[4], vn[4];
#pragma unroll
    for (int e = 0; e < 8; ++e) { int ke = (two ? 32 * (e & 3) : Lq0 + 32 * (e - 4)) + srow; ke = ke < 0 ? 0 : ke; const int rs = res_base + (two ? e >> 2 : 0);
        const bf16_t* p = QKV + (size_t)(rb + ke * d + rs) * PITCH + sch * 8; kr[e] = *(const u32x4*)(p + kcol); vr[e] = *(const u32x4*)(p + vcol); }
    bf16x8 qf[8];
    { const bf16_t* qp = QKV + (size_t)tq * PITCH + qcol + hi * 8;
#pragma unroll
      for (int d0 = 0; d0 < 8; ++d0) qf[d0] = *(const bf16x8*)(qp + d0 * 16); }
#pragma unroll
    for (int e = 0; e < 4; ++e) { const int ke = (two ? 0 : Lq0 + 32 * (e + 4)) + srow;
        const bf16_t* p = QKV + (size_t)(rb + ke * d + res_base) * PITCH + sch * 8; kn[e] = *(const u32x4*)(p + kcol); vn[e] = *(const u32x4*)(p + vcol); }
#pragma unroll
    for (int e = 0; e < 8; ++e) { *(LAS u32x4*)(lds + e * WF_SLOT + koff) = kr[e]; *(LAS u32x4*)(lds + e * WF_SLOT + voff) = vr[e]; }
    __syncthreads();
    f32x16 o[4];
#pragma unroll
    for (int d0 = 0; d0 < 4; ++d0) o[d0] = (f32x16){0.f, 0.f, 0.f, 0.f, 0.f, 0.f, 0.f, 0.f, 0.f, 0.f, 0.f, 0.f, 0.f, 0.f, 0.f, 0.f};
    float st0 = -INFINITY, st1 = 0.f;
    const int NS = two ? 4 : 5;
#pragma unroll
    for (int j = 0; j < 5; ++j) {
        if (j < NS) {
            const int sb = wq - (NS - 1) + j;
            const bool valid = two ? (sb >= 0) : (Lq0 + 32 * sb >= 0);
            if (valid) { const int sl = two ? cls * 4 + sb : (sb + 4 >= 9 ? sb - 5 : sb + 4);
                const int mask = (j == NS - 1) ? 1 : ((!two && j == 0) ? 2 : 0);
                subblock<1, WF_VS>(lds + sl * WF_SLOT, lds + sl * WF_SLOT + 32 * KST, qf, o, st0, st1, mask, r32, hi, lane); }
            if (j < 4) { const int ss = two ? 8 : (j + 8) % 9;
                *(LAS u32x4*)(lds + ss * WF_SLOT + koff) = kn[j]; *(LAS u32x4*)(lds + ss * WF_SLOT + voff) = vn[j]; }
            __syncthreads();
        }
    }
    bf16_t* orow = OB + (size_t)tq * 1024 + ocol + 4 * hi;
    const float l = xhalf_sum(st1); const float inv = 1.f / l;
#pragma unroll
    for (int d0 = 0; d0 < 4; ++d0)
#pragma unroll
        for (int i4 = 0; i4 < 4; ++i4) { u32x2 w; w.x = pk2(o[d0][4 * i4] * inv, o[d0][4 * i4 + 1] * inv); w.y = pk2(o[d0][4 * i4 + 2] * inv, o[d0][4 * i4 + 3] * inv);
            *(u32x2*)(orow + 32 * d0 + 8 * i4) = w; }
    if (hi == 0) lse_out[(size_t)tq * 8 + (ocol >> 7)] = st0 + __builtin_amdgcn_logf(l);
}
}

__device__ __forceinline__ float gelu_tanh(float x) { const float t = x * (1.f + 0.044715f * x * x) * 2.3022081983f; return x / (1.f + __builtin_amdgcn_exp2f(-t)); }

#define XB_TMO      128
#define XB_XCNT(j)  (256  + 64 * (j))
#define XB_XSUB(j)  (1280 + 64 * (j))
#define XB_XGEN(j)  (2304 + 64 * (j))
#define XB_TOP      3328
#define XB_TOPGEN   3392
#define XCD_BAR_WORDS 3456
#define XB_SPIN_CAP (1u << 18)

__device__ __forceinline__ unsigned xb_ld(unsigned* p)              { return __hip_atomic_load(p, __ATOMIC_RELAXED, __HIP_MEMORY_SCOPE_AGENT); }
__device__ __forceinline__ unsigned xb_add(unsigned* p, unsigned v) { return __hip_atomic_fetch_add(p, v, __ATOMIC_RELAXED, __HIP_MEMORY_SCOPE_AGENT); }
__device__ __forceinline__ unsigned xb_xcc_id() { return (unsigned)__builtin_amdgcn_s_getreg((3 << 11) | 20) & 0xFu; }
#define XB_SPIN(cond, bar) do { unsigned _sp = 0; while (cond) { __builtin_amdgcn_s_sleep(1); \
    if ((++_sp & 255u) == 0u) { if (xb_ld(&(bar)[XB_TMO])) break; if (_sp > XB_SPIN_CAP) { atomicAdd(&(bar)[XB_TMO], 1u); break; } } } } while (0)

struct XcdBarrier {
    unsigned* bar; unsigned x;
    volatile LAS unsigned* st;
};

__device__ __forceinline__ XcdBarrier xcd_barrier_post(unsigned* bar, volatile LAS unsigned* st) {
    XcdBarrier b; b.bar = bar; b.x = xb_xcc_id(); b.st = st;
    if (threadIdx.x == 0) (void)xb_add(&bar[XB_XCNT(b.x)], 1u);
    return b;
}
__device__ __forceinline__ void xcd_barrier_complete(unsigned* bar, unsigned x, unsigned& nloc, unsigned& nx) {
    const unsigned G = gridDim.x * gridDim.y * gridDim.z;
    unsigned sum, cnt, mine, sp = 0u;
    for (;;) {
        sum = 0u; cnt = 0u; mine = 0u;
#pragma unroll
        for (unsigned j = 0; j < 16; ++j) { const unsigned c = xb_ld(&bar[XB_XCNT(j)]); sum += c; cnt += (c > 0u) ? 1u : 0u; mine = (j == x) ? c : mine; }
        if (sum == G) break;
        __builtin_amdgcn_s_sleep(1);
        if ((++sp & 255u) == 0u) { if (xb_ld(&bar[XB_TMO])) break; if (sp > XB_SPIN_CAP) { atomicAdd(&bar[XB_TMO], 1u); break; } }
    }
    nloc = mine > 0u ? mine : 1u; nx = cnt > 0u ? cnt : 1u;
}

__device__ __forceinline__ void xcd_barrier(const XcdBarrier& b) {
    asm volatile("s_waitcnt vmcnt(0)" ::: "memory");
    __syncthreads();
    if (threadIdx.x == 0) {
        unsigned* bar = b.bar;
        __builtin_amdgcn_s_waitcnt(0);
        unsigned nloc = b.st[0], nx = b.st[1];
        if (nloc == 0u) { xcd_barrier_complete(bar, b.x, nloc, nx); b.st[0] = nloc; b.st[1] = nx; }
        const unsigned old = xb_add(&bar[XB_XSUB(b.x)], 1u);
        const unsigned gen = old / nloc;
        if (old + 1u == (gen + 1u) * nloc) {
            __builtin_amdgcn_fence(__ATOMIC_RELEASE, "agent");
            asm volatile("s_waitcnt vmcnt(0)" ::: "memory");
            const unsigned og = xb_add(&bar[XB_TOP], 1u);
            const unsigned tg = og / nx;
            if (og + 1u == (tg + 1u) * nx) xb_add(&bar[XB_TOPGEN], 1u);
            else XB_SPIN(xb_ld(&bar[XB_TOPGEN]) == tg, bar);
            __builtin_amdgcn_fence(__ATOMIC_ACQUIRE, "agent");
            xb_add(&bar[XB_XGEN(b.x)], 1u);
            asm volatile("s_waitcnt vmcnt(0)" ::: "memory");
        } else {
            XB_SPIN(xb_ld(&bar[XB_XGEN(b.x)]) == gen, bar);
            __builtin_amdgcn_fence(__ATOMIC_ACQUIRE, "agent");
            asm volatile("s_waitcnt vmcnt(0)" ::: "memory");
        }
    }
    __syncthreads();
}

struct Args { const float* in[13]; float* out; unsigned char* ws; int ph_lo, ph_hi; };
constexpr int N_PHASES = 9;
#ifndef DUP_P1
#define DUP_P1 1
#endif
#ifndef DUP_P6
#define DUP_P6 1
#endif
#ifndef DUP_SB
#define DUP_SB 1
#endif
#ifndef DUP_DL
#define DUP_DL 1
#endif
#ifndef DUP_SB
#define DUP_SB 1
#endif
#ifndef DUP_DL
#define DUP_DL 1
#endif
#ifndef DUP_P3
#define DUP_P3 1
#endif
#ifndef DUP_P5
#define DUP_P5 1
#endif
#ifndef DUP_P8
#define DUP_P8 1
#endif
#ifndef DUP_P0
#define DUP_P0 1
#endif
#ifndef DUP_P2
#define DUP_P2 1
#endif

__global__ void __launch_bounds__(NTHREADS, 2) fwd_kernel(Args args) {
    extern __shared__ __attribute__((aligned(16))) unsigned char lds_raw[];
    LAS unsigned char* lds = (LAS unsigned char*)lds_raw;
    cg::grid_group grid = cg::this_grid();
    const int tid = threadIdx.x, lane = tid & 63, wave = __builtin_amdgcn_readfirstlane(tid >> 6);
    const int G = gridDim.x, bx = blockIdx.x;
    const int gw = bx * NWAVES + wave, NGW = G * NWAVES;
    const int lo = args.ph_lo, hi_ph = args.ph_hi;
    unsigned char* ws = args.ws;
    const float* x = args.in[0]; const float* g_pre_mix = args.in[1]; const float* g_post_mix = args.in[2]; const float* g_pre_ffn = args.in[3]; const float* g_post_ffn = args.in[4];
    const float* w_in = args.in[5]; const float* g_sb = args.in[6]; const float* g_dil = args.in[7]; const float* w_out = args.in[8]; const float* w_up = args.in[9];
    const float* conv_w = args.in[10]; const float* conv_b = args.in[11]; const float* w_down = args.in[12];
    float* out = args.out;
    bf16_t* Win_t = (bf16_t*)(ws + WS_WIN); bf16_t* Wout_t = (bf16_t*)(ws + WS_WOUT); bf16_t* Wup_t = (bf16_t*)(ws + WS_WUP); bf16_t* Wdown_t = (bf16_t*)(ws + WS_WDOWN);
    bf16_t* XN = (bf16_t*)(ws + WS_XN); bf16_t* QKV = (bf16_t*)(ws + WS_QKV); bf16_t* MIXED = (bf16_t*)(ws + WS_MIXED); bf16_t* MIXOUT = (bf16_t*)(ws + WS_MIXOUT);
    bf16_t* OB0 = (bf16_t*)(ws + WS_OB0); bf16_t* OB1 = (bf16_t*)(ws + WS_OB1); bf16_t* OB2 = (bf16_t*)(ws + WS_OB2); float* LSE = (float*)(ws + WS_LSE);
    float* HALO = (float*)(ws + WS_HALO); unsigned* FLAGS = (unsigned*)(ws + WS_FLAGS); bf16_t* Y = (bf16_t*)(ws + WS_Y); float* RSTD1 = (float*)(ws + WS_RSTD1); bf16_t* F = (bf16_t*)(ws + WS_XN); float* ROPE = (float*)(ws + WS_ROPE);
    volatile LAS unsigned* bar_st = (volatile LAS unsigned*)(lds + BARST_OFF);
    if (tid < 2) bar_st[tid] = 0u;
    __syncthreads();
    unsigned* BAR = (unsigned*)(ws + WS_BAR);
    XcdBarrier xbar = xcd_barrier_post(BAR, bar_st);
    if (args.ph_hi > 1000) grid.sync();
#define IN(k) (lo <= (k) && (k) < hi_ph)
#define SEAM(k) do { if (IN(k) && IN((k) + 1)) xcd_barrier(xbar); } while (0)

    for (int rep_ = 0; rep_ < DUP_P0; ++rep_) if (IN(0)) {
        LAS float* scr = (LAS float*)(lds + wave * 16384);
        constexpr int I_IN = (D / 64) * (NQKV / 32), I_OUT = (D / 64) * (D / 32), I_UP = (D / 64) * (NUP / 32), I_DN = (DFF / 64) * (D / 32);
        constexpr int NITEMS = I_IN + I_OUT + I_UP; (void)I_DN;
        for (int it = gw; it < NITEMS; it += NGW) {
            int r = it;
            if (r < I_IN) { p0_transpose_item<1>(w_in, D, NQKV, Win_t, scr, r, lane); continue; } r -= I_IN;
            if (r < I_OUT) { p0_transpose_item<0>(w_out, D, D, Wout_t, scr, r, lane); continue; } r -= I_OUT;
            p0_transpose_item<2>(w_up, D, NUP, Wup_t, scr, r, lane);
        }
        for (int e = bx * NTHREADS + tid; e < SEQ * 64; e += G * NTHREADS) { const int pos = e >> 6, i = e & 63;
            const float inv_freq = exp2f(-(float)i * (13.287712379549449f / 64.f));
            const float ang = (float)pos * inv_freq; float rev = ang * 0.15915494309189535f; rev = rev - floorf(rev);
            ROPE[2 * e] = __builtin_amdgcn_cosf(rev); ROPE[2 * e + 1] = __builtin_amdgcn_sinf(rev); }
        for (int m = gw; m < M; m += NGW) rms_row_to_bf16(x + (size_t)m * D, g_pre_mix, XN + (size_t)m * D, lane);
    }
    SEAM(0);
    if (IN(1)) {
        pg8::Gemm g{XN, Win_t, M, NQKV, D}; pg8::StaticOrder S; S.init(M, NQKV, G, bx);
        pg8::EpiQKV E{QKV, ROPE, C2};
        pg8::gemm_phase<pg8::EpiQKV, pg8::StaticOrder, true, true>(lds, g, S, E);
    }
#if DUP_P1 > 1
    if (IN(1)) {
        pg8::Gemm g{XN, Win_t, M, NQKV, D}; pg8::StaticOrder S; S.init(M, NQKV, G, bx);
        pg8::EpiQKV E{QKV, ROPE, C2};
        pg8::gemm_phase<pg8::EpiQKV, pg8::StaticOrder, true, true>(lds, g, S, E);
    }
#endif
    SEAM(1);
    if (IN(2)) {
        const int vcu = (G % 8 == 0) ? (bx % 8) * (G / 8) + bx / 8 : bx;
        for (int p = vcu; p < 256; p += G) { const int bh = p >> 2, s = p & 3, b = bh >> 3, h = bh & 7;
            for (int k = 0; k < 2; ++k) { const int qb = k ? 7 - s : s;
                att::attn_unit<0>(lds, QKV, b * SEQ, 1, 0, 1 << 20, 4 * qb + 4, 256 * qb + 192, -64, 0, 256 * qb + 32 * wave, h * HD, 1024 + h * HD, 2048 + h * HD, MIXED, D, h * HD, g_sb, nullptr); } }
        for (int p = vcu; p < 256; p += G) { const int bh = p >> 2, sub = p & 3, b = bh >> 3, h = bh & 7; const int qc = 3072 + h * HD, kc = 4096 + h * HD, vc = 5120 + h * HD;
#pragma unroll 1
            for (int k = 0; k < 6; ++k) { const int br = k >> 1, kk = k & 1;
                const int d = br == 0 ? 1 : (br == 1 ? 4 : 16);
                const int res_base = br == 0 ? 0 : (br == 1 ? sub : 2 * (2 * sub + kk));
                const int Lq0 = br == 0 ? 256 * (2 * sub + kk) : (br == 1 ? 256 * kk : 0);
                bf16_t* OB = br == 0 ? OB0 : (br == 1 ? OB1 : OB2);
                att::dil_wf_unit(lds, QKV, b * SEQ, d, res_base, br == 2, Lq0, qc, kc, vc, OB, LSE + (size_t)br * M * 8, h * HD); }
        }
    }
    SEAM(2);
    if (IN(3)) {
        for (int m = gw; m < M; m += NGW) { const int hh = lane >> 3;
            const float l0 = LSE[(size_t)m * 8 + hh], l1 = LSE[(size_t)(M + m) * 8 + hh], l2 = LSE[(size_t)(2 * M + m) * 8 + hh];
            const float mx = fmaxf(l0, fmaxf(l1, l2)); float w0 = __builtin_amdgcn_exp2f(l0 - mx), w1 = __builtin_amdgcn_exp2f(l1 - mx), w2 = __builtin_amdgcn_exp2f(l2 - mx);
            const float wi = 1.f / (w0 + w1 + w2); w0 *= wi; w1 *= wi; w2 *= wi;
            float v[16]; float ss = 0.f;
#pragma unroll
            for (int c = 0; c < 2; ++c) { const size_t off = (size_t)m * 1024 + lane * 16 + c * 8;
                const u32x4 a0 = ldntu4((const u32x4*)(OB0 + off)), a1 = ldntu4((const u32x4*)(OB1 + off)), a2 = ldntu4((const u32x4*)(OB2 + off));
#pragma unroll
                for (int j = 0; j < 4; ++j) { v[c * 8 + 2 * j] = w0 * bf_lo(a0[j]) + w1 * bf_lo(a1[j]) + w2 * bf_lo(a2[j]); v[c * 8 + 2 * j + 1] = w0 * bf_hi(a0[j]) + w1 * bf_hi(a1[j]) + w2 * bf_hi(a2[j]); } }
#pragma unroll
            for (int j = 0; j < 16; ++j) ss += v[j] * v[j];
            ss += __shfl_xor(ss, 1); ss += __shfl_xor(ss, 2); ss += __shfl_xor(ss, 4);
            const float rstd = 1.f / sqrtf(ss * (1.f / HD) + RMS_EPS);
#pragma unroll
            for (int c = 0; c < 2; ++c) { const f32x4 ga = *(const f32x4*)(g_dil + lane * 16 + c * 8), gb = *(const f32x4*)(g_dil + lane * 16 + c * 8 + 4);
                u32x4 w; w.x = pk2(v[c * 8] * rstd * ga[0], v[c * 8 + 1] * rstd * ga[1]); w.y = pk2(v[c * 8 + 2] * rstd * ga[2], v[c * 8 + 3] * rstd * ga[3]);
                w.z = pk2(v[c * 8 + 4] * rstd * gb[0], v[c * 8 + 5] * rstd * gb[1]); w.w = pk2(v[c * 8 + 6] * rstd * gb[2], v[c * 8 + 7] * rstd * gb[3]);
                *(u32x4*)(MIXED + (size_t)m * D + 1024 + lane * 16 + c * 8) = w; } }
    }
    SEAM(3);
    if (IN(4)) {
        pg8::Gemm g{MIXED, Wout_t, M, D, D}; pg8::StaticOrder S; S.init(M, D, G, bx);
        pg8::EpiBf16 E{MIXOUT, D};
        pg8::gemm_phase<pg8::EpiBf16, pg8::StaticOrder, true, true>(lds, g, S, E);
    }
    SEAM(4);
    if (IN(5)) {
        for (int m = gw; m < M; m += NGW) {
            const u32x2* mr = (const u32x2*)(MIXOUT + (size_t)m * D) + lane; const f32x4* xr = (const f32x4*)(x + (size_t)m * D) + lane;
            f32x4 v[8]; float s = 0.f;
#pragma unroll
            for (int j = 0; j < 8; ++j) { const u32x2 w = ldntu2(mr + 64 * j); v[j] = (f32x4){bf_lo(w.x), bf_hi(w.x), bf_lo(w.y), bf_hi(w.y)}; s += (v[j][0] * v[j][0] + v[j][1] * v[j][1]) + (v[j][2] * v[j][2] + v[j][3] * v[j][3]); }
            const float rstd = 1.f / sqrtf(wave_sum(s) * (1.f / D) + RMS_EPS);
            float s2 = 0.f; if (lane == 0) RSTD1[m] = rstd;
#pragma unroll
            for (int j = 0; j < 8; ++j) { const f32x4 g = ((const f32x4*)g_post_mix)[lane + 64 * j]; const f32x4 xv = ldnt4(xr + 64 * j);
                v[j] = xv + v[j] * rstd * g; s2 += (v[j][0] * v[j][0] + v[j][1] * v[j][1]) + (v[j][2] * v[j][2] + v[j][3] * v[j][3]); }
            const float rstd2 = 1.f / sqrtf(wave_sum(s2) * (1.f / D) + RMS_EPS);
            u32x2* o8 = (u32x2*)(XN + (size_t)m * D) + lane;
#pragma unroll
            for (int j = 0; j < 8; ++j) { const f32x4 g = ((const f32x4*)g_pre_ffn)[lane + 64 * j]; u32x2 w; w.x = pk2(v[j][0] * rstd2 * g[0], v[j][1] * rstd2 * g[1]); w.y = pk2(v[j][2] * rstd2 * g[2], v[j][3] * rstd2 * g[3]); o8[64 * j] = w; }
        }
    }
    SEAM(5);
    if (IN(6)) {
        pg8::Gemm g{XN, Wup_t, M, NUP, D}; pg8::StaticOrder S; S.init(M, NUP, G, bx);
        pg8::EpiConv E{Y, conv_w, conv_b, HALO, FLAGS, lds + XCH_OFF, NUP / 256};
        pg8::gemm_phase<pg8::EpiConv, pg8::StaticOrder, true, true>(lds, g, S, E);
        { const int nun = (M / 256) * (NUP / 256); const int rem = nun % G; const int first = rem, nw = (G - first) * NWAVES;
          if (bx >= first) { LAS float* scr = (LAS float*)(lds + wave * 16384); constexpr int I_DN2 = (DFF / 64) * (D / 32);
              for (int it = (bx - first) * NWAVES + wave; it < I_DN2; it += nw) p0_transpose_item<0>(w_down, DFF, D, Wdown_t, scr, it, lane); } }
    }
#if DUP_P6 > 1
    if (IN(6)) {
        pg8::Gemm g{XN, Wup_t, M, NUP, D}; pg8::StaticOrder S; S.init(M, NUP, G, bx);
        pg8::EpiConv E{Y, conv_w, conv_b, HALO, FLAGS, lds + XCH_OFF, NUP / 256};
        pg8::gemm_phase<pg8::EpiConv, pg8::StaticOrder, true, true>(lds, g, S, E);
    }
#endif
    SEAM(6);
    if (IN(7)) {
        pg8::Gemm g{Y, Wdown_t, M, D, DFF}; pg8::StaticOrder S; S.init(M, D, G, bx);
        pg8::EpiBf16 E{F, D};
        pg8::gemm_phase<pg8::EpiBf16, pg8::StaticOrder, true, true>(lds, g, S, E);
    }
    SEAM(7);
    if (IN(8)) {
        for (int m = gw; m < M; m += NGW) {
            const u32x2* fr_ = (const u32x2*)(F + (size_t)m * D) + lane; f32x4* orow = (f32x4*)(out + (size_t)m * D) + lane;
            f32x4 v[8]; float s = 0.f;
#pragma unroll
            for (int j = 0; j < 8; ++j) { const u32x2 w = ldntu2(fr_ + 64 * j); v[j] = (f32x4){bf_lo(w.x), bf_hi(w.x), bf_lo(w.y), bf_hi(w.y)}; s += (v[j][0] * v[j][0] + v[j][1] * v[j][1]) + (v[j][2] * v[j][2] + v[j][3] * v[j][3]); }
            const float rstd = 1.f / sqrtf(wave_sum(s) * (1.f / D) + RMS_EPS);
            const float rstd1 = RSTD1[m]; const u32x2* mr = (const u32x2*)(MIXOUT + (size_t)m * D) + lane; const f32x4* xr = (const f32x4*)(x + (size_t)m * D) + lane;
#pragma unroll
            for (int j = 0; j < 8; ++j) { const f32x4 g = ((const f32x4*)g_post_ffn)[lane + 64 * j]; const f32x4 g1 = ((const f32x4*)g_post_mix)[lane + 64 * j];
                const u32x2 w = ldntu2(mr + 64 * j); const f32x4 mo = (f32x4){bf_lo(w.x), bf_hi(w.x), bf_lo(w.y), bf_hi(w.y)};
                const f32x4 x1 = ldnt4(xr + 64 * j) + mo * rstd1 * g1;
                stnt4(orow + 64 * j, x1 + v[j] * rstd * g); }
        }
    }
#undef IN
#undef SEAM
}

extern "C" void kernel_launch(void* const* d_in, const int* in_sizes, int n_in, void* d_out, int out_size, void* d_ws, size_t ws_size, hipStream_t stream) {
    static int grid = 0;
    if (grid == 0) {
        if (n_in != 13 || in_sizes[0] != M * D || out_size != M * D || ws_size < WS_END) { fprintf(stderr, "kernel_launch: unexpected shapes (n_in %d, in0 %d, out %d, ws %zu)\n", n_in, n_in > 0 ? in_sizes[0] : -1, out_size, ws_size); grid = -1; return; }
        int dev = 0, cus = 0, per_cu = 0;
        hipGetDevice(&dev); hipDeviceGetAttribute(&cus, hipDeviceAttributeMultiprocessorCount, dev);
        if (hipFuncSetAttribute((const void*)fwd_kernel, hipFuncAttributeMaxDynamicSharedMemorySize, LDS_BYTES) != hipSuccess) { fprintf(stderr, "kernel_launch: hipFuncSetAttribute failed\n"); grid = -1; return; }
        if (hipOccupancyMaxActiveBlocksPerMultiprocessor(&per_cu, (const void*)fwd_kernel, NTHREADS, LDS_BYTES) != hipSuccess || per_cu < 1) { fprintf(stderr, "kernel_launch: occupancy query says %d\n", per_cu); per_cu = 1; }
        (void)hipGetLastError();
        grid = cus * (per_cu > 1 ? 1 : per_cu);
        if (grid <= 0) grid = 256;
    }
    if (grid < 0) return;
    if (hipMemsetAsync(d_ws, 0, 131072, stream) != hipSuccess) { fprintf(stderr, "kernel_launch: memset failed\n"); return; }
    Args a{};
    for (int i = 0; i < 13; ++i) a.in[i] = (const float*)d_in[i];
    a.out = (float*)d_out; a.ws = (unsigned char*)d_ws;
#if ONE_LAUNCH
    a.ph_lo = 0; a.ph_hi = N_PHASES;
    void* kargs[] = {&a};
    hipError_t e = hipLaunchCooperativeKernel((const void*)fwd_kernel, dim3(grid), dim3(NTHREADS), kargs, LDS_BYTES, stream);
    if (e != hipSuccess) fprintf(stderr, "kernel_launch: cooperative launch failed: %s (grid %d)\n", hipGetErrorString(e), grid);
#else
    for (int ph = 0; ph < N_PHASES; ++ph) { a.ph_lo = ph; a.ph_hi = ph + 1; hipLaunchKernelGGL(fwd_kernel, dim3(grid), dim3(NTHREADS), LDS_BYTES, stream, a); }
#endif
}
```

```cpp
#include <hip/hip_runtime.h>
#include <hip/hip_cooperative_groups.h>
#include <cstdio>
#include <cstdint>
namespace cg = cooperative_groups;
#ifndef ONE_LAUNCH
#define ONE_LAUNCH 1
#endif
namespace pg8 {
#define PG8_LAS __attribute__((address_space(3)))
typedef unsigned short bf16_t;
typedef short bf16x8 __attribute__((ext_vector_type(8)));
typedef float f32x4 __attribute__((ext_vector_type(4)));
typedef unsigned u32x4 __attribute__((ext_vector_type(4)));
constexpr int BM = 256, BK = 64, HALF = 128, HTB = HALF * BK * 2  , STAGE_BYTES = 8 * HTB, NXCD = 8, WGM = 2;

__host__ __device__ __forceinline__ int lds_byte(int r, int c) { const int st = (r >> 4) * 2 + (c >> 5), rr = r & 15, cc = c & 31, ob = rr * 64 + cc * 2; return st * 1024 + (ob ^ (((ob >> 9) & 1) << 5)); }
__host__ __device__ __forceinline__ void stage_rc(int b, int& R, int& C) { const int st = b / 1024, sb = b % 1024, swz = sb ^ (((sb >> 9) & 1) << 5); R = (st >> 1) * 16 + swz / 64; C = (st & 1) * 32 + (swz % 64) / 2; }
__host__ __device__ __forceinline__ int perm32(int rho) { const int n = rho >> 4, i = rho & 15; return 8 * (i >> 2) + 4 * n + (i & 3); }

struct Unit { int pm, pn; };
struct Gemm { const bf16_t* A; const bf16_t* Bt; int M, N, K; };

struct StaticOrder {
    int nM, nN, nwg, G, c;
    __host__ __device__ void init(int M, int N, int G_, int c_) { nM = M / BM; nN = N / BM; nwg = nM * nN; G = G_; c = c_; }
    __host__ __device__ bool next(int i, Unit& u) const {
        const long L = (long)i * G + c; if (L >= nwg) return false;
        int wgid = (int)L; { const int q = nwg / NXCD, r = nwg % NXCD, xcd = wgid % NXCD, off = wgid / NXCD; wgid = (xcd < r ? xcd * (q + 1) : r * (q + 1) + (xcd - r) * q) + off; }
        const int nig = WGM * nN, gid = wgid / nig, fm = gid * WGM, gsz = (nM - fm) < WGM ? (nM - fm) : WGM;
        u.pm = fm + ((wgid % nig) % gsz); u.pn = (wgid % nig) / gsz; return true;
    }
    __device__ __forceinline__ void a_ready(const Unit&) const {}
    __device__ __forceinline__ void done(const Unit&) const {}
};

__device__ __forceinline__ unsigned cvt_pk_bf16(float lo, float hi) { unsigned r; asm volatile("v_cvt_pk_bf16_f32 %0, %1, %2" : "=v"(r) : "v"(lo), "v"(hi)); return r; }
struct EpiBf16 {
    static constexpr bool PERM = true, AFTER_DRAIN = false;
    bf16_t* O; int ldc;
    __device__ __forceinline__ void operator()(const f32x4 (&acc)[2][2][4][2], const Unit& u, int wr, int wc, int fr, int fq) const {
        const int row0 = u.pm * BM + wr * 64 + fr; const int col0 = u.pn * BM + wc * 32 + 8 * fq;
#pragma unroll
        for (int ai = 0; ai < 2; ++ai)
#pragma unroll
            for (int m = 0; m < 4; ++m) { bf16_t* rowp = O + (size_t)(row0 + ai * HALF + m * 16) * ldc + col0;
#pragma unroll
                for (int bj = 0; bj < 2; ++bj) { const f32x4 v0 = acc[ai][bj][m][0], v1 = acc[ai][bj][m][1];
                    u32x4 w; w.x = cvt_pk_bf16(v0[0], v0[1]); w.y = cvt_pk_bf16(v0[2], v0[3]); w.z = cvt_pk_bf16(v1[0], v1[1]); w.w = cvt_pk_bf16(v1[2], v1[3]);
                    *(u32x4*)(rowp + bj * HALF) = w; } }
    }
};
struct EpiQKV {
    static constexpr bool PERM = true, AFTER_DRAIN = false;
    bf16_t* O; const float* rope; float c2;
    __device__ __forceinline__ void operator()(const f32x4 (&acc)[2][2][4][2], const Unit& u, int wr, int wc, int fr, int fq) const {
        const int row0 = u.pm * BM + wr * 64 + fr; const int col0 = u.pn * BM + wc * 32 + 8 * fq;
        const int seg = u.pn >> 2; const float sc = (seg == 0 || seg == 3) ? c2 : 1.f; const bool rot = (seg == 3 || seg == 4);
#pragma unroll
        for (int ai = 0; ai < 2; ++ai)
#pragma unroll
            for (int m = 0; m < 4; ++m) { const int row = row0 + ai * HALF + m * 16; bf16_t* rowp = O + (size_t)row * 6144 + col0; const int pos = row & 2047;
#pragma unroll
                for (int bj = 0; bj < 2; ++bj) { f32x4 v0 = acc[ai][bj][m][0], v1 = acc[ai][bj][m][1];
                    if (rot) { const int dp = ((col0 + bj * HALF) & 127) >> 1; const f32x4* tp = (const f32x4*)(rope + ((size_t)pos * 64 + dp) * 2);
                        const f32x4 t0 = tp[0], t1 = tp[1];
                        v0 = (f32x4){v0[0] * t0[0] - v0[1] * t0[1], v0[1] * t0[0] + v0[0] * t0[1], v0[2] * t0[2] - v0[3] * t0[3], v0[3] * t0[2] + v0[2] * t0[3]};
                        v1 = (f32x4){v1[0] * t1[0] - v1[1] * t1[1], v1[1] * t1[0] + v1[0] * t1[1], v1[2] * t1[2] - v1[3] * t1[3], v1[3] * t1[2] + v1[2] * t1[3]}; }
                    v0 = v0 * sc; v1 = v1 * sc;
                    u32x4 w; w.x = cvt_pk_bf16(v0[0], v0[1]); w.y = cvt_pk_bf16(v0[2], v0[3]); w.z = cvt_pk_bf16(v1[0], v1[1]); w.w = cvt_pk_bf16(v1[2], v1[3]);
                    *(u32x4*)(rowp + bj * HALF) = w; } }
    }
};

typedef unsigned u32x2 __attribute__((ext_vector_type(2)));

template <int CTRL> __device__ __forceinline__ float dppf(float x) { return __builtin_bit_cast(float, __builtin_amdgcn_update_dpp(0, __builtin_bit_cast(int, x), CTRL, 0xf, 0xf, false)); }
template <int CTRL> __device__ __forceinline__ f32x4 dpp4(f32x4 v) { return (f32x4){dppf<CTRL>(v[0]), dppf<CTRL>(v[1]), dppf<CTRL>(v[2]), dppf<CTRL>(v[3])}; }
__device__ __forceinline__ float gelu_tanh_f(float x) { const float t = x * (1.f + 0.044715f * x * x) * 2.3022081983f; return x * __builtin_amdgcn_rcpf(1.f + __builtin_amdgcn_exp2f(-t)); }
__device__ __forceinline__ f32x4 ldh(const float* p) {
    const unsigned long long a = __hip_atomic_load((const unsigned long long*)p, __ATOMIC_RELAXED, __HIP_MEMORY_SCOPE_AGENT), b = __hip_atomic_load((const unsigned long long*)p + 1, __ATOMIC_RELAXED, __HIP_MEMORY_SCOPE_AGENT);
    return (f32x4){__builtin_bit_cast(float, (unsigned)a), __builtin_bit_cast(float, (unsigned)(a >> 32)), __builtin_bit_cast(float, (unsigned)b), __builtin_bit_cast(float, (unsigned)(b >> 32))}; }
template <int CTRL> __device__ __forceinline__ float dppo(float old, float x) { return __builtin_bit_cast(float, __builtin_amdgcn_update_dpp(__builtin_bit_cast(int, old), __builtin_bit_cast(int, x), CTRL, 0xf, 0xf, false)); }
template <int CTRL> __device__ __forceinline__ f32x4 dppo4(f32x4 o, f32x4 v) { return (f32x4){dppo<CTRL>(o[0], v[0]), dppo<CTRL>(o[1], v[1]), dppo<CTRL>(o[2], v[2]), dppo<CTRL>(o[3], v[3])}; }
struct EpiConv {
    static constexpr bool PERM = true, AFTER_DRAIN = false;
    bf16_t* Y; const float* cw; const float* cb; float* halo; unsigned* flags; PG8_LAS unsigned char* xch; int nN;
    __device__ __forceinline__ void operator()(const f32x4 (&acc)[2][2][4][2], const Unit& u, int wr, int wc, int fr, int fq) const {
        constexpr int NUPc = 11008, DFFc = 5504;
        const int lane = fq * 16 + fr;
        const bool need_prev = (u.pm & 7) != 0;
        if (fr >= 14) {
#pragma unroll
            for (int ai = 0; ai < 2; ++ai)
#pragma unroll
                for (int bj = 0; bj < 2; ++bj)
#pragma unroll
                    for (int n = 0; n < 2; ++n) *(PG8_LAS f32x4*)(xch + ((((ai * 2 + wr) * 4 + wc) * 2 + (fr - 14)) * 64 + bj * 32 + 8 * fq + 4 * n) * 4) = acc[ai][bj][3][n];
            if (wr == 1) { float* hp = halo + ((size_t)(u.pm * nN + u.pn) * 2 + (fr - 14)) * 256 + wc * 32 + 8 * fq;
#pragma unroll
                for (int bj = 0; bj < 2; ++bj)
#pragma unroll
                    for (int n = 0; n < 2; ++n) { const f32x4 v = acc[1][bj][3][n]; unsigned long long* q = (unsigned long long*)(hp + bj * 128 + 4 * n);
                        const float e0 = v[0], e1 = v[1], e2 = v[2], e3 = v[3];
                        __hip_atomic_store(q, ((unsigned long long)__float_as_uint(e1) << 32) | __float_as_uint(e0), __ATOMIC_RELAXED, __HIP_MEMORY_SCOPE_AGENT);
                        __hip_atomic_store(q + 1, ((unsigned long long)__float_as_uint(e3) << 32) | __float_as_uint(e2), __ATOMIC_RELAXED, __HIP_MEMORY_SCOPE_AGENT); } }
        }
        if (wr == 1) { asm volatile("s_waitcnt vmcnt(0)" ::: "memory"); if (lane == 0) __hip_atomic_fetch_add(flags + u.pm * nN + u.pn, 1u, __ATOMIC_RELAXED, __HIP_MEMORY_SCOPE_AGENT); }
        if (need_prev && wr == 0 && wc == 0) {
            const unsigned* fp = flags + (u.pm - 1) * nN + u.pn;
            for (unsigned sp_ = 0; (unsigned)__builtin_amdgcn_readfirstlane(__hip_atomic_load(fp, __ATOMIC_RELAXED, __HIP_MEMORY_SCOPE_AGENT)) < 4u && sp_ < (1u << 22); ++sp_) __builtin_amdgcn_s_sleep(2);
            __builtin_amdgcn_fence(__ATOMIC_ACQUIRE, "agent");
            asm volatile("s_waitcnt vmcnt(0)" ::: "memory");
        }
        asm volatile("s_waitcnt lgkmcnt(0)" ::: "memory"); __builtin_amdgcn_s_barrier(); asm volatile("" ::: "memory");
        u32x2 ypk[2][4];
#pragma unroll
        for (int n = 0; n < 2; ++n) {
            const int fcol = u.pn * 128 + wc * 32 + 8 * fq + 4 * n;
            f32x4 wg[3], wv[3];
#pragma unroll
            for (int j = 0; j < 3; ++j) { wg[j] = *(const f32x4*)(cw + (size_t)j * NUPc + fcol); wv[j] = *(const f32x4*)(cw + (size_t)j * NUPc + DFFc + fcol); }
            const f32x4 bg = *(const f32x4*)(cb + fcol), bv = *(const f32x4*)(cb + DFFc + fcol);
#pragma unroll
            for (int ai = 0; ai < 2; ++ai) {
                f32x4 h1g, h2g, h1v, h2v;
                const int ci = 2 * ai + wr;
                if (ci == 0) {
                    if (need_prev) { const float* hp = halo + ((size_t)((u.pm - 1) * nN + u.pn) * 2) * 256 + wc * 32 + 8 * fq + 4 * n;
                        h2g = ldh(hp); h2v = ldh(hp + 128); h1g = ldh(hp + 256); h1v = ldh(hp + 256 + 128); }
                    else { h1g = h2g = h1v = h2v = (f32x4){0.f, 0.f, 0.f, 0.f}; }
                } else { const int cp = ci - 1; const PG8_LAS unsigned char* xp = xch + ((((cp >> 1) * 2 + (cp & 1)) * 4 + wc) * 2 * 64 + 8 * fq + 4 * n) * 4;
                    h2g = *(const PG8_LAS f32x4*)(xp); h2v = *(const PG8_LAS f32x4*)(xp + 32 * 4); h1g = *(const PG8_LAS f32x4*)(xp + 64 * 4); h1v = *(const PG8_LAS f32x4*)(xp + 64 * 4 + 32 * 4); }
                f32x4 og1 = h1g, ov1 = h1v, og2, ov2;
#pragma unroll
                for (int e = 0; e < 4; ++e) { og2[e] = fr == 1 ? h1g[e] : h2g[e]; ov2[e] = fr == 1 ? h1v[e] : h2v[e]; }
#pragma unroll
                for (int m = 0; m < 4; ++m) {
                    const f32x4 g0 = acc[ai][0][m][n], v0 = acc[ai][1][m][n];
                    const f32x4 g1 = dppo4<0x111>(og1, g0), g2 = dppo4<0x112>(og2, g0), v1 = dppo4<0x111>(ov1, v0), v2 = dppo4<0x112>(ov2, v0);
                    if (m < 3) { og1 = dpp4<0x121>(g0); og2 = dpp4<0x122>(g0); ov1 = dpp4<0x121>(v0); ov2 = dpp4<0x122>(v0); }
                    const f32x4 gt = bg + wg[0] * g2 + wg[1] * g1 + wg[2] * g0, vl = bv + wv[0] * v2 + wv[1] * v1 + wv[2] * v0;
                    u32x2 w; w.x = cvt_pk_bf16(gelu_tanh_f(gt[0]) * vl[0], gelu_tanh_f(gt[1]) * vl[1]); w.y = cvt_pk_bf16(gelu_tanh_f(gt[2]) * vl[2], gelu_tanh_f(gt[3]) * vl[3]);
                    if (n == 0) ypk[ai][m] = w;
                    else { u32x4 o; o.x = ypk[ai][m].x; o.y = ypk[ai][m].y; o.z = w.x; o.w = w.y;
                        *(u32x4*)(Y + (size_t)(u.pm * BM + ai * HALF + wr * 64 + m * 16 + fr) * DFFc + u.pn * 128 + wc * 32 + 8 * fq) = o; }
                }
            }
        }
    }
};
template <class Epi, class Sched, bool ALIGN_EPI = false, bool SP2 = false>
__device__ __forceinline__ void gemm_phase(PG8_LAS unsigned char* lds, const Gemm g, const Sched& S, const Epi& E) {
    const int tid = threadIdx.x, wid = __builtin_amdgcn_readfirstlane(tid >> 6), lane = tid & 63, wr = wid >> 2, wc = wid & 3, fr = lane & 15, fq = lane >> 4;
    const int K = g.K, nt = K / BK;
    unsigned voffA[2], voffB[2];
#pragma unroll
    for (int i = 0; i < 2; ++i) { int R, C; stage_rc(tid * 16 + i * 8192, R, C); const int Rb = Epi::PERM ? ((R & ~31) + perm32(R & 31)) : R;
        voffA[i] = (unsigned)(R * K + C) * 2u; voffB[i] = (unsigned)(Rb * K + C) * 2u; }
    const size_t kstep = (size_t)(BK * 2);
    const size_t hstep = (size_t)HALF * K * 2;
    const size_t tstep = 2 * hstep;
    const unsigned ldsw = (unsigned)wid * 1024u;
    const int aoff = lds_byte(wr * 64 + fr, fq * 8), boff = lds_byte(wc * 32 + fr, fq * 8);
#define PG8_SA(b, h) (((b) * 2 + (h)) * HTB)
#define PG8_SB(b, h) ((4 + (b) * 2 + (h)) * HTB)
#define PG8_STAGE(bufoff, gbase, voff) do { _Pragma("unroll") for (int _i = 0; _i < 2; ++_i) \
        __builtin_amdgcn_global_load_lds((const unsigned*)((const char*)(gbase) + (voff)[_i]), (PG8_LAS unsigned*)(lds + (bufoff) + ldsw + _i * 8192), 16, 0, 0); } while (0)
#define PG8_LDA(dst, b, h) do { _Pragma("unroll") for (int m = 0; m < 4; ++m) _Pragma("unroll") for (int k = 0; k < 2; ++k) dst[m][k] = *(const PG8_LAS bf16x8*)(lds + PG8_SA(b, h) + aoff + m * 2048 + k * 1024); } while (0)
#define PG8_LDB(dst, b, h) do { _Pragma("unroll") for (int n = 0; n < 2; ++n) _Pragma("unroll") for (int k = 0; k < 2; ++k) dst[n][k] = *(const PG8_LAS bf16x8*)(lds + PG8_SB(b, h) + boff + n * 2048 + k * 1024); } while (0)
#define PG8_MMA(ai, bj, At, Bt) do { __builtin_amdgcn_s_setprio(1); _Pragma("unroll") for (int m = 0; m < 4; ++m) _Pragma("unroll") for (int n = 0; n < 2; ++n) _Pragma("unroll") for (int k = 0; k < 2; ++k) \
        acc[ai][bj][m][n] = __builtin_amdgcn_mfma_f32_16x16x32_bf16(Bt[n][k], At[m][k], acc[ai][bj][m][n], 0, 0, 0); __builtin_amdgcn_s_setprio(0); } while (0)
#define PG8_WAIT_V(n) asm volatile("s_waitcnt vmcnt(" #n ")" ::: "memory")
#define PG8_WAIT_L(n) asm volatile("s_waitcnt lgkmcnt(" #n ")" ::: "memory")
#define PG8_BAR __builtin_amdgcn_s_barrier()
#define PG8_SCHED __builtin_amdgcn_sched_barrier(0)
    Unit cur, nxt; int ui = 0;
    if (!S.next(0, cur)) return;
    f32x4 acc[2][2][4][2];
#pragma unroll
    for (int a = 0; a < 2; ++a)
#pragma unroll
        for (int b = 0; b < 2; ++b)
#pragma unroll
            for (int m = 0; m < 4; ++m)
#pragma unroll
                for (int n = 0; n < 2; ++n) acc[a][b][m][n] = (f32x4){0.f, 0.f, 0.f, 0.f};
    bf16x8 At[4][2], B0[2][2], B1[2][2];
    const char* cA = (const char*)g.A + (size_t)cur.pm * tstep; const char* cB = (const char*)g.Bt + (size_t)cur.pn * tstep;
    S.a_ready(cur);
    if constexpr (SP2) {
        PG8_STAGE(PG8_SB(0, 0), cB, voffB); PG8_STAGE(PG8_SB(0, 1), cB + hstep, voffB); PG8_STAGE(PG8_SA(0, 0), cA, voffA); PG8_STAGE(PG8_SA(0, 1), cA + hstep, voffA);
        if (wr == 1) PG8_BAR;
        PG8_WAIT_V(2); PG8_BAR;
        PG8_STAGE(PG8_SB(1, 0), cB + kstep, voffB); PG8_STAGE(PG8_SA(1, 0), cA + kstep, voffA); PG8_STAGE(PG8_SB(1, 1), cB + hstep + kstep, voffB);
        PG8_WAIT_V(6); PG8_BAR;
    } else {
        PG8_STAGE(PG8_SB(0, 0), cB, voffB); PG8_STAGE(PG8_SA(0, 0), cA, voffA); PG8_STAGE(PG8_SB(0, 1), cB + hstep, voffB); PG8_STAGE(PG8_SA(0, 1), cA + hstep, voffA);
        if (wr == 1) PG8_BAR;
        PG8_WAIT_V(4); PG8_BAR;
        PG8_STAGE(PG8_SB(1, 0), cB + kstep, voffB); PG8_STAGE(PG8_SA(1, 0), cA + kstep, voffA); PG8_STAGE(PG8_SB(1, 1), cB + hstep + kstep, voffB);
        PG8_WAIT_V(6); PG8_BAR;
    }
    for (;;) {
        const bool has_next = S.next(ui + 1, nxt);
        const char* nA = has_next ? (const char*)g.A + (size_t)nxt.pm * tstep : cA; const char* nB = has_next ? (const char*)g.Bt + (size_t)nxt.pn * tstep : cB;
        for (int t = 0; t < nt; t += 2) {
            const bool last = (t == nt - 2);
            const char* a1 = cA + (size_t)(t + 1) * kstep;
            const char* a2 = last ? nA : cA + (size_t)(t + 2) * kstep; const char* b2 = last ? nB : cB + (size_t)(t + 2) * kstep;
            const char* a3 = a2 + kstep; const char* b3 = b2 + kstep;
            if (last && has_next) S.a_ready(nxt);
            if constexpr (SP2) {
            PG8_LDB(B0, 0, 0); PG8_LDB(B1, 0, 1); PG8_SCHED; PG8_LDA(At, 0, 0); PG8_STAGE(PG8_SA(1, 1), a1 + hstep, voffA);
            PG8_WAIT_V(8); PG8_WAIT_L(0); PG8_BAR; PG8_MMA(0, 0, At, B0); PG8_MMA(0, 1, At, B1); PG8_BAR; PG8_SCHED;
            PG8_LDA(At, 0, 1); PG8_STAGE(PG8_SB(0, 0), b2, voffB); PG8_STAGE(PG8_SB(0, 1), b2 + hstep, voffB); PG8_STAGE(PG8_SA(0, 0), a2, voffA);
            PG8_WAIT_V(8); PG8_WAIT_L(0); PG8_BAR; PG8_MMA(1, 0, At, B0); PG8_MMA(1, 1, At, B1); PG8_BAR; PG8_SCHED;
            PG8_LDB(B0, 1, 0); PG8_LDB(B1, 1, 1); PG8_SCHED; PG8_LDA(At, 1, 0); PG8_STAGE(PG8_SA(0, 1), a2 + hstep, voffA);
            PG8_WAIT_V(8); PG8_WAIT_L(0); PG8_BAR; PG8_MMA(0, 0, At, B0); PG8_MMA(0, 1, At, B1); PG8_BAR; PG8_SCHED;
            PG8_LDA(At, 1, 1); PG8_STAGE(PG8_SB(1, 0), b3, voffB); PG8_STAGE(PG8_SB(1, 1), b3 + hstep, voffB); PG8_STAGE(PG8_SA(1, 0), a3, voffA);
            PG8_WAIT_V(8); PG8_WAIT_L(0); PG8_BAR; PG8_MMA(1, 0, At, B0); PG8_MMA(1, 1, At, B1); PG8_BAR; PG8_SCHED;
            } else {
            PG8_LDB(B0, 0, 0); PG8_SCHED; PG8_LDA(At, 0, 0); PG8_STAGE(PG8_SA(1, 1), a1 + hstep, voffA);
            PG8_WAIT_L(8); PG8_BAR; PG8_WAIT_L(0); PG8_MMA(0, 0, At, B0); PG8_BAR; PG8_SCHED;
            PG8_LDB(B1, 0, 1); PG8_STAGE(PG8_SB(0, 0), b2, voffB);
            PG8_BAR; PG8_WAIT_L(0); PG8_MMA(0, 1, At, B1); PG8_BAR;
            PG8_LDA(At, 0, 1); PG8_STAGE(PG8_SA(0, 0), a2, voffA);
            PG8_BAR; PG8_WAIT_L(0); PG8_MMA(1, 0, At, B0); PG8_BAR; PG8_SCHED;
            PG8_STAGE(PG8_SB(0, 1), b2 + hstep, voffB);
            PG8_WAIT_V(6); PG8_BAR; PG8_MMA(1, 1, At, B1); PG8_BAR;
            PG8_LDB(B0, 1, 0); PG8_SCHED; PG8_LDA(At, 1, 0); PG8_STAGE(PG8_SA(0, 1), a2 + hstep, voffA);
            PG8_WAIT_L(8); PG8_BAR; PG8_WAIT_L(0); PG8_MMA(0, 0, At, B0); PG8_BAR; PG8_SCHED;
            PG8_LDB(B1, 1, 1); PG8_STAGE(PG8_SB(1, 0), b3, voffB);
            PG8_BAR; PG8_WAIT_L(0); PG8_MMA(0, 1, At, B1); PG8_BAR;
            PG8_LDA(At, 1, 1); PG8_STAGE(PG8_SA(1, 0), a3, voffA);
            PG8_BAR; PG8_WAIT_L(0); PG8_MMA(1, 0, At, B0); PG8_BAR; PG8_SCHED;
            PG8_STAGE(PG8_SB(1, 1), b3 + hstep, voffB);
            PG8_WAIT_V(6); PG8_BAR; PG8_MMA(1, 1, At, B1); PG8_BAR;
            }
        }
        if constexpr (ALIGN_EPI) { if (wr == 0) PG8_BAR; }
        if constexpr (!Epi::AFTER_DRAIN) { E(acc, cur, wr, wc, fr, fq); S.done(cur); }
        if (!has_next) break;
#pragma unroll
        for (int a = 0; a < 2; ++a)
#pragma unroll
            for (int b = 0; b < 2; ++b)
#pragma unroll
                for (int m = 0; m < 4; ++m)
#pragma unroll
                    for (int n = 0; n < 2; ++n) acc[a][b][m][n] = (f32x4){0.f, 0.f, 0.f, 0.f};
        cur = nxt; cA = nA; cB = nB; ++ui;
        if constexpr (ALIGN_EPI) { if (wr == 1) PG8_BAR; }
    }
    PG8_WAIT_V(0);
    if constexpr (!ALIGN_EPI) { if (wr == 0) PG8_BAR; }
    PG8_BAR;
    if constexpr (Epi::AFTER_DRAIN) { E.fused(acc, cur, wr, wc, fr, fq, lds, wid, lane); S.done(cur); }
#undef PG8_SA
#undef PG8_SB
#undef PG8_STAGE
#undef PG8_LDA
#undef PG8_LDB
#undef PG8_MMA
#undef PG8_WAIT_V
#undef PG8_WAIT_L
#undef PG8_BAR
#undef PG8_SCHED
}
}
using pg8::bf16_t; using pg8::bf16x8; using pg8::f32x4; using pg8::u32x4;
#define LAS __attribute__((address_space(3)))
typedef float f32x16 __attribute__((ext_vector_type(16)));
using pg8::u32x2;
typedef short s16x4 __attribute__((ext_vector_type(4)));

constexpr int SEQ = 2048, BATCH = 8, M = BATCH * SEQ, D = 2048, NQKV = 6144, DFF = 5504, NUP = 2 * DFF, HD = 128;
constexpr float RMS_EPS = 1e-6f;
constexpr float C2 = 0.08838834764831845f * 1.4426950408889634f;
constexpr int NWAVES = 8, NTHREADS = 512;
constexpr int MHALF = M / 2;
constexpr size_t MiB = 1u << 20;
constexpr size_t WS_ROPE = 1 * MiB;
constexpr size_t WS_WIN = 2 * MiB, WS_WOUT = 26 * MiB, WS_WUP = 34 * MiB, WS_WDOWN = 77 * MiB;
constexpr size_t WS_XN = 100 * MiB;
constexpr size_t WS_OB2 = 100 * MiB, WS_LSE = 132 * MiB;
constexpr size_t WS_QKV = 164 * MiB;
constexpr size_t WS_MIXED = 356 * MiB;
constexpr size_t WS_MIXOUT = 420 * MiB;
constexpr size_t WS_OB0 = 420 * MiB, WS_OB1 = 452 * MiB;
constexpr size_t WS_Y = 164 * MiB;
constexpr size_t WS_HALO = 340 * MiB;
constexpr size_t WS_BAR = 65536;
constexpr size_t WS_RSTD1 = 348 * MiB;
constexpr size_t WS_FLAGS = 0;
constexpr size_t WS_END = 484 * MiB;
constexpr int RING_BYTES = 131072, XCH_OFF = RING_BYTES, LDS_BYTES = RING_BYTES + 8192 + 4096;

__device__ __forceinline__ u32x4 ldntu4(const u32x4* p) { return __builtin_nontemporal_load(p); }
__device__ __forceinline__ u32x2 ldntu2(const u32x2* p) { return __builtin_nontemporal_load(p); }
__device__ __forceinline__ f32x4 ldnt4(const f32x4* p) { return __builtin_nontemporal_load(p); }
__device__ __forceinline__ void stnt4(f32x4* p, f32x4 v) { __builtin_nontemporal_store(v, p); }
__device__ __forceinline__ float wave_sum(float v) {
#pragma unroll
    for (int o = 1; o < 64; o <<= 1) v += __shfl_xor(v, o);
    return v;
}
__device__ __forceinline__ unsigned f2bf(float f) { unsigned u = __builtin_bit_cast(unsigned, f); return (u + 0x7fffu + ((u >> 16) & 1u)) >> 16; }
__device__ __forceinline__ unsigned pk2(float lo, float hi) { unsigned r; asm("v_cvt_pk_bf16_f32 %0, %1, %2" : "=v"(r) : "v"(lo), "v"(hi)); return r; }
__device__ __forceinline__ float bf_lo(unsigned w) { return __builtin_bit_cast(float, w << 16); }
__device__ __forceinline__ float bf_hi(unsigned w) { return __builtin_bit_cast(float, w & 0xffff0000u); }

__device__ __forceinline__ int win_rowmap(int n) { const int seg = n >> 10; if (seg == 3 || seg == 4) { const int w = n & 1023, hh = w >> 7, d = w & 127; return (seg << 10) + (hh << 7) + 2 * (d & 63) + (d >> 6); } return n; }
__device__ __forceinline__ int up_rowmap(int n) { const int f = n < DFF ? n : n - DFF; return (f >> 7) * 256 + (n < DFF ? 0 : 128) + (f & 127); }
template <int MAP> __device__ __forceinline__ void p0_transpose_item(const float* __restrict__ W, int K, int N, bf16_t* WT, LAS float* scr, int item, int lane) {
    const int nblk = N / 32, kb = item / nblk, nb = item % nblk, k0 = 64 * kb, n0 = 32 * nb;
#pragma unroll 8
    for (int i = 0; i < 32; ++i) { const int kk = 2 * i + (lane >> 5); scr[kk * 33 + (lane & 31)] = __builtin_nontemporal_load(W + (size_t)(k0 + kk) * N + n0 + (lane & 31)); }
    asm volatile("s_waitcnt lgkmcnt(0)" ::: "memory");
    const int c = lane & 7;
#pragma unroll
    for (int j = 0; j < 4; ++j) { const int n = (lane >> 3) + 8 * j; const LAS float* s = scr + (8 * c) * 33 + n;
        u32x4 o; o.x = pk2(s[0 * 33], s[1 * 33]); o.y = pk2(s[2 * 33], s[3 * 33]); o.z = pk2(s[4 * 33], s[5 * 33]); o.w = pk2(s[6 * 33], s[7 * 33]);
        const int drow = MAP == 1 ? win_rowmap(n0 + n) : (MAP == 2 ? up_rowmap(n0 + n) : (n0 + n));
        *(u32x4*)(WT + (size_t)drow * K + k0 + 8 * c) = o; }
    asm volatile("s_waitcnt lgkmcnt(0)" ::: "memory");
}
__device__ __forceinline__ void rms_row_to_bf16(const float* xrow, const float* gain, bf16_t* orow, int lane) {
    const f32x4* xr = (const f32x4*)xrow + lane; f32x4 v[8]; float s = 0.f;
#pragma unroll
    for (int j = 0; j < 8; ++j) { v[j] = ldnt4(xr + 64 * j); s += (v[j][0] * v[j][0] + v[j][1] * v[j][1]) + (v[j][2] * v[j][2] + v[j][3] * v[j][3]); }
    const float rstd = 1.f / sqrtf(wave_sum(s) * (1.f / D) + RMS_EPS);
    const f32x4* gr = (const f32x4*)gain + lane; u32x2* o8 = (u32x2*)orow + lane;
#pragma unroll
    for (int j = 0; j < 8; ++j) { const f32x4 g = gr[64 * j]; u32x2 w; w.x = pk2(v[j][0] * rstd * g[0], v[j][1] * rstd * g[1]); w.y = pk2(v[j][2] * rstd * g[2], v[j][3] * rstd * g[3]); o8[64 * j] = w; }
}

namespace att {
constexpr int KST = 272, VST = 320, KTB = 64 * KST, VTB = 64 * VST, BUFB = KTB + VTB;
constexpr int PITCH = NQKV;
constexpr float SB_DONE_BITS = 48.f;
__device__ __forceinline__ constexpr int crow(int r, int hi) { return (r & 3) + 8 * (r >> 2) + 4 * hi; }
struct HalfPair { float lo, up; };
__device__ __forceinline__ HalfPair xhalf(float v) { const auto rr = __builtin_amdgcn_permlane32_swap(__float_as_uint(v), __float_as_uint(v), false, false); return HalfPair{__uint_as_float(rr[0]), __uint_as_float(rr[1])}; }
__device__ __forceinline__ float xhalf_sum(float v) { const HalfPair h = xhalf(v); return h.lo + h.up; }
__device__ __forceinline__ float xhalf_max(float v) { const HalfPair h = xhalf(v); return __builtin_fmaxf(h.lo, h.up); }
__device__ __forceinline__ s16x4 vtr(const LAS unsigned char* p) { return __builtin_bit_cast(s16x4, __builtin_amdgcn_ds_read_tr16_b64_v4i16((LAS s16x4*)p)); }

template <int KIND> __device__ __forceinline__ void subblock(const LAS unsigned char* kt, const LAS unsigned char* vt, const bf16x8 (&qf)[8], f32x16 (&o)[4], float& st0, float& st1, const int mask, const int r32, const int hi, const int lane) {
    f32x16 z = {0.f, 0.f, 0.f, 0.f, 0.f, 0.f, 0.f, 0.f, 0.f, 0.f, 0.f, 0.f, 0.f, 0.f, 0.f, 0.f}, z1 = z;
    const LAS unsigned char* kp = kt + r32 * KST + hi * 16;
#pragma unroll
    for (int d0 = 0; d0 < 8; d0 += 2) { const bf16x8 kf = *(const LAS bf16x8*)(kp + d0 * 32), kg = *(const LAS bf16x8*)(kp + d0 * 32 + 32);
        z = __builtin_amdgcn_mfma_f32_32x32x16_bf16(kf, qf[d0], z, 0, 0, 0); z1 = __builtin_amdgcn_mfma_f32_32x32x16_bf16(kg, qf[d0 + 1], z1, 0, 0, 0); }
    z = z + z1;
    float p[16];
    if (KIND == 0) {
        float L[16];
#pragma unroll
        for (int r = 0; r < 16; ++r) { const float zz = __builtin_fminf(z[r], 120.f); const float e = __builtin_amdgcn_exp2f(zz); float l2 = __builtin_amdgcn_logf(1.f + e);
            if (mask == 1 && !(crow(r, hi) < r32)) l2 = 0.f; L[r] = l2; }
        HalfPair gp[4];
#pragma unroll
        for (int i = 0; i < 4; ++i) gp[i] = xhalf((L[4 * i] + L[4 * i + 1]) + (L[4 * i + 2] + L[4 * i + 3]));
        float t[4]; t[3] = 0.f; t[2] = gp[3].lo + gp[3].up; t[1] = t[2] + (gp[2].lo + gp[2].up); t[0] = t[1] + (gp[1].lo + gp[1].up);
        const float T = t[0] + (gp[0].lo + gp[0].up);
#pragma unroll
        for (int i = 0; i < 4; ++i) { const float b = st0 + t[i] + (hi == 0 ? gp[i].up : 0.f);
            const float w3 = b + L[4 * i + 3], w2 = w3 + L[4 * i + 2], w1 = w2 + L[4 * i + 1], w0 = w1 + L[4 * i + 0];
            p[4 * i + 0] = z[4 * i + 0] - w0; p[4 * i + 1] = z[4 * i + 1] - w1; p[4 * i + 2] = z[4 * i + 2] - w2; p[4 * i + 3] = z[4 * i + 3] - w3; }
#pragma unroll
        for (int r = 0; r < 16; ++r) { float a = __builtin_amdgcn_exp2f(p[r]); if (mask == 1 && !(crow(r, hi) < r32)) a = 0.f; p[r] = a; }
        st0 += T;
    } else {
        float rm = -INFINITY;
#pragma unroll
        for (int r = 0; r < 16; ++r) { float zz = z[r]; if (mask == 1 && crow(r, hi) > r32) zz = -INFINITY; if (mask == 2 && crow(r, hi) < r32) zz = -INFINITY; p[r] = zz; rm = __builtin_fmaxf(rm, zz); }
        rm = xhalf_max(rm);
        if (__any(rm > st0 + 8.f)) { const float mn = __builtin_fmaxf(st0, rm); const float alpha = __builtin_amdgcn_exp2f(st0 - mn); st0 = mn; st1 *= alpha;
#pragma unroll
            for (int d0 = 0; d0 < 4; ++d0) o[d0] = o[d0] * alpha; }
        float s = 0.f;
#pragma unroll
        for (int r = 0; r < 16; ++r) { p[r] = __builtin_amdgcn_exp2f(p[r] - st0); s += p[r]; }
        st1 += s;
    }
    u32x4 pw0, pw1;
    pw0.x = pg8::cvt_pk_bf16(p[0], p[1]); pw0.y = pg8::cvt_pk_bf16(p[2], p[3]); pw0.z = pg8::cvt_pk_bf16(p[4], p[5]); pw0.w = pg8::cvt_pk_bf16(p[6], p[7]);
    pw1.x = pg8::cvt_pk_bf16(p[8], p[9]); pw1.y = pg8::cvt_pk_bf16(p[10], p[11]); pw1.z = pg8::cvt_pk_bf16(p[12], p[13]); pw1.w = pg8::cvt_pk_bf16(p[14], p[15]);
    const bf16x8 pa0 = __builtin_bit_cast(bf16x8, pw0), pa1 = __builtin_bit_cast(bf16x8, pw1);
    const LAS unsigned char* vp = vt + (4 * hi + ((lane & 15) >> 2)) * VST + ((lane >> 4) & 1) * 32 + (lane & 3) * 8;
#pragma unroll
    for (int d0 = 0; d0 < 4; ++d0) {
        const s16x4 a0 = vtr(vp + d0 * 64), a1 = vtr(vp + d0 * 64 + 8 * VST), b0 = vtr(vp + d0 * 64 + 16 * VST), b1 = vtr(vp + d0 * 64 + 24 * VST);
        const bf16x8 va = (bf16x8){a0[0], a0[1], a0[2], a0[3], a1[0], a1[1], a1[2], a1[3]}, vb = (bf16x8){b0[0], b0[1], b0[2], b0[3], b1[0], b1[1], b1[2], b1[3]};
        o[d0] = __builtin_amdgcn_mfma_f32_32x32x16_bf16(va, pa0, o[d0], 0, 0, 0);
        o[d0] = __builtin_amdgcn_mfma_f32_32x32x16_bf16(vb, pa1, o[d0], 0, 0, 0);
    }
}

template <int KIND> __device__ __forceinline__ void attn_unit(LAS unsigned char* lds, const bf16_t* __restrict__ QKV, int rb, int dil, int res0, int isplit, int nt, int ks_first, int kstep,
                                                             int res_w, int lw0, int qcol, int kcol, int vcol, bf16_t* Out, int out_pitch, int ocol, const float* gain, float* lse_out) {
    const int tid = threadIdx.x, lane = tid & 63, r32 = lane & 31, hi = lane >> 5;
    const int tq = rb + (lw0 + r32) * dil + res_w;
    bf16x8 qf[8];
    { const bf16_t* qp = QKV + (size_t)tq * PITCH + qcol + hi * 8;
#pragma unroll
      for (int d0 = 0; d0 < 8; ++d0) qf[d0] = *(const bf16x8*)(qp + d0 * 16); }
    f32x16 o[4];
#pragma unroll
    for (int d0 = 0; d0 < 4; ++d0) o[d0] = (f32x16){0.f, 0.f, 0.f, 0.f, 0.f, 0.f, 0.f, 0.f, 0.f, 0.f, 0.f, 0.f, 0.f, 0.f, 0.f, 0.f};
    float st0 = (KIND == 0) ? 0.f : -INFINITY, st1 = 0.f;
    const int srow = tid >> 4, sch = tid & 15;
    u32x4 krA[2], vrA[2], krB[2], vrB[2];
#define ATT_TILE_GEOM(i, res_i, ks_i) const int sp_ = ((i) >= isplit) ? 1 : 0; const int res_i = res0 + sp_; const int ks_i = ks_first + kstep * ((i) - (sp_ ? isplit : 0));
#define ATT_LOAD(i, KR, VR) do { ATT_TILE_GEOM(i, res_i, ks_i) _Pragma("unroll") for (int c = 0; c < 2; ++c) { const int tok = rb + (ks_i + srow + 32 * c) * dil + res_i; const bf16_t* p = QKV + (size_t)tok * PITCH + sch * 8; \
        KR[c] = *(const u32x4*)(p + kcol); VR[c] = *(const u32x4*)(p + vcol); } } while (0)
#define ATT_STORE(buf, KR, VR) do { _Pragma("unroll") for (int c = 0; c < 2; ++c) { *(LAS u32x4*)(lds + (buf) * BUFB + (srow + 32 * c) * KST + sch * 16) = KR[c]; *(LAS u32x4*)(lds + (buf) * BUFB + KTB + (srow + 32 * c) * VST + sch * 16) = VR[c]; } } while (0)
#define ATT_ITER(i, KRA, VRA, KRB, VRB) do { \
        { const int ip_ = ((i) + 2 < nt) ? (i) + 2 : nt - 1; ATT_LOAD(ip_, KRB, VRB); }     \
        { ATT_TILE_GEOM(i, res_i, ks_i) \
          if (res_i == res_w) { \
            const LAS unsigned char* kb = lds + ((i) & 1) * BUFB; const LAS unsigned char* vb = kb + KTB; \
            _Pragma("unroll") for (int ss = 0; ss < 2; ++ss) { const int sub = (KIND == 0) ? 1 - ss : ss; const int kss = ks_i + 32 * sub; \
                const bool need = (kss <= lw0) && (KIND == 0 || kss >= lw0 - 128); \
                if (need) { const int mask = (kss == lw0) ? 1 : ((KIND == 1 && kss == lw0 - 128) ? 2 : 0); \
                    subblock<KIND>(kb + sub * 32 * KST, vb + sub * 32 * VST, qf, o, st0, st1, mask, r32, hi, lane); } } \
          } } \
        if (KIND == 0) { const int dn_ = __all(st0 > SB_DONE_BITS) ? 1 : 0; if (lane == 0) dflag[((i) & 1) * 8 + wid] = dn_; } \
        ATT_STORE(((i) + 1) & 1, KRA, VRA);     \
        __syncthreads(); \
        if (KIND == 0) { const u32x4 fa_ = *(const LAS u32x4*)(dflag + ((i) & 1) * 8), fb_ = *(const LAS u32x4*)(dflag + ((i) & 1) * 8 + 4); \
            stop_ = (fa_.x & fa_.y & fa_.z & fa_.w & fb_.x & fb_.y & fb_.z & fb_.w) != 0u; } } while (0)
    ATT_LOAD(0, krA, vrA); ATT_STORE(0, krA, vrA); ATT_LOAD(1, krA, vrA); __syncthreads();
    LAS unsigned* dflag = (LAS unsigned*)(lds + 2 * BUFB); const int wid = tid >> 6; bool stop_ = false;
    for (int i = 0; i < nt; i += 2) { ATT_ITER(i, krA, vrA, krB, vrB); if (stop_) break; ATT_ITER(i + 1, krB, vrB, krA, vrA); if (stop_) break; }
    if (KIND == 0) __syncthreads();
#undef ATT_ITER
#undef ATT_LOAD
#undef ATT_STORE
#undef ATT_TILE_GEOM
    LAS unsigned char* stg = lds + 40960 + (tid >> 6) * 8704;
    float scale;
    if (KIND == 0) {
        float ss = 0.f;
#pragma unroll
        for (int d0 = 0; d0 < 4; ++d0)
#pragma unroll
            for (int r = 0; r < 16; ++r) ss += o[d0][r] * o[d0][r];
        ss = xhalf_sum(ss);
        scale = 1.f / sqrtf(ss * (1.f / HD) + RMS_EPS);
    } else {
        const float l = xhalf_sum(st1); scale = 1.f / l;
        if (hi == 0) lse_out[(size_t)tq * 8 + (ocol >> 7)] = st0 + __builtin_amdgcn_logf(l);
    }
#pragma unroll
    for (int d0 = 0; d0 < 4; ++d0)
#pragma unroll
        for (int i4 = 0; i4 < 4; ++i4) { f32x4 g = {1.f, 1.f, 1.f, 1.f}; if (KIND == 0) g = *(const f32x4*)(gain + ocol + 32 * d0 + 8 * i4 + 4 * hi);
            u32x2 w; w.x = pk2(o[d0][4 * i4] * scale * g[0], o[d0][4 * i4 + 1] * scale * g[1]); w.y = pk2(o[d0][4 * i4 + 2] * scale * g[2], o[d0][4 * i4 + 3] * scale * g[3]);
            *(LAS u32x2*)(stg + r32 * 272 + (32 * d0 + 8 * i4 + 4 * hi) * 2) = w; }
    asm volatile("s_waitcnt lgkmcnt(0)" ::: "memory");
#pragma unroll
    for (int it = 0; it < 8; ++it) { const int row = it * 4 + (lane >> 4), ch = lane & 15;
        const u32x4 v = *(const LAS u32x4*)(stg + row * 272 + ch * 16);
        const int tok = rb + (lw0 + row) * dil + res_w;
        *(u32x4*)(Out + (size_t)tok * out_pitch + ocol + ch * 8) = v; }
    asm volatile("s_waitcnt lgkmcnt(0)" ::: "memory");
}
}

__device__ __forceinline__ float gelu_tanh(float x) { const float t = x * (1.f + 0.044715f * x * x) * 2.3022081983f; return x / (1.f + __builtin_amdgcn_exp2f(-t)); }

#define XB_TMO      128
#define XB_XCNT(j)  (256  + 64 * (j))
#define XB_XSUB(j)  (1280 + 64 * (j))
#define XB_XGEN(j)  (2304 + 64 * (j))
#define XB_TOP      3328
#define XB_TOPGEN   3392
#define XCD_BAR_WORDS 3456
#define XB_SPIN_CAP (1u << 18)

__device__ __forceinline__ unsigned xb_ld(unsigned* p)              { return __hip_atomic_load(p, __ATOMIC_RELAXED, __HIP_MEMORY_SCOPE_AGENT); }
__device__ __forceinline__ unsigned xb_add(unsigned* p, unsigned v) { return __hip_atomic_fetch_add(p, v, __ATOMIC_RELAXED, __HIP_MEMORY_SCOPE_AGENT); }
__device__ __forceinline__ unsigned xb_xcc_id() { return (unsigned)__builtin_amdgcn_s_getreg((3 << 11) | 20) & 0xFu; }
#define XB_SPIN(cond, bar) do { unsigned _sp = 0; while (cond) { __builtin_amdgcn_s_sleep(1); \
    if ((++_sp & 255u) == 0u) { if (xb_ld(&(bar)[XB_TMO])) break; if (_sp > XB_SPIN_CAP) { atomicAdd(&(bar)[XB_TMO], 1u); break; } } } } while (0)

struct XcdBarrier {
    unsigned* bar; unsigned x;
    volatile LAS unsigned* st;
};

__device__ __forceinline__ XcdBarrier xcd_barrier_post(unsigned* bar, volatile LAS unsigned* st) {
    XcdBarrier b; b.bar = bar; b.x = xb_xcc_id(); b.st = st;
    if (threadIdx.x == 0) (void)xb_add(&bar[XB_XCNT(b.x)], 1u);
    return b;
}
__device__ __forceinline__ void xcd_barrier_complete(unsigned* bar, unsigned x, unsigned& nloc, unsigned& nx) {
    const unsigned G = gridDim.x * gridDim.y * gridDim.z;
    unsigned sum, cnt, mine, sp = 0u;
    for (;;) {
        sum = 0u; cnt = 0u; mine = 0u;
#pragma unroll
        for (unsigned j = 0; j < 16; ++j) { const unsigned c = xb_ld(&bar[XB_XCNT(j)]); sum += c; cnt += (c > 0u) ? 1u : 0u; mine = (j == x) ? c : mine; }
        if (sum == G) break;
        __builtin_amdgcn_s_sleep(1);
        if ((++sp & 255u) == 0u) { if (xb_ld(&bar[XB_TMO])) break; if (sp > XB_SPIN_CAP) { atomicAdd(&bar[XB_TMO], 1u); break; } }
    }
    nloc = mine > 0u ? mine : 1u; nx = cnt > 0u ? cnt : 1u;
}

__device__ __forceinline__ void xcd_barrier(const XcdBarrier& b) {
    asm volatile("s_waitcnt vmcnt(0)" ::: "memory");
    __syncthreads();
    if (threadIdx.x == 0) {
        unsigned* bar = b.bar;
        __builtin_amdgcn_s_waitcnt(0);
        unsigned nloc = b.st[0], nx = b.st[1];
        if (nloc == 0u) { xcd_barrier_complete(bar, b.x, nloc, nx); b.st[0] = nloc; b.st[1] = nx; }
        const unsigned old = xb_add(&bar[XB_XSUB(b.x)], 1u);
        const unsigned gen = old / nloc;
        if (old + 1u == (gen + 1u) * nloc) {
            __builtin_amdgcn_fence(__ATOMIC_RELEASE, "agent");
            asm volatile("s_waitcnt vmcnt(0)" ::: "memory");
            const unsigned og = xb_add(&bar[XB_TOP], 1u);
            const unsigned tg = og / nx;
            if (og + 1u == (tg + 1u) * nx) xb_add(&bar[XB_TOPGEN], 1u);
            else XB_SPIN(xb_ld(&bar[XB_TOPGEN]) == tg, bar);
            __builtin_amdgcn_fence(__ATOMIC_ACQUIRE, "agent");
            xb_add(&bar[XB_XGEN(b.x)], 1u);
            asm volatile("s_waitcnt vmcnt(0)" ::: "memory");
        } else {
            XB_SPIN(xb_ld(&bar[XB_XGEN(b.x)]) == gen, bar);
            __builtin_amdgcn_fence(__ATOMIC_ACQUIRE, "agent");
            asm volatile("s_waitcnt vmcnt(0)" ::: "memory");
        }
    }
    __syncthreads();
}

struct Args { const float* in[13]; float* out; unsigned char* ws; int ph_lo, ph_hi; };
constexpr int N_PHASES = 9;
#ifndef DUP_P1
#define DUP_P1 1
#endif
#ifndef DUP_P6
#define DUP_P6 1
#endif
#ifndef DUP_SB
#define DUP_SB 1
#endif
#ifndef DUP_DL
#define DUP_DL 1
#endif
#ifndef DUP_SB
#define DUP_SB 1
#endif
#ifndef DUP_DL
#define DUP_DL 1
#endif
#ifndef DUP_P3
#define DUP_P3 1
#endif
#ifndef DUP_P5
#define DUP_P5 1
#endif
#ifndef DUP_P8
#define DUP_P8 1
#endif
#ifndef DUP_P0
#define DUP_P0 1
#endif
#ifndef DUP_P2
#define DUP_P2 1
#endif

__global__ void __launch_bounds__(NTHREADS, 2) fwd_kernel(Args args) {
    extern __shared__ __attribute__((aligned(16))) unsigned char lds_raw[];
    LAS unsigned char* lds = (LAS unsigned char*)lds_raw;
    cg::grid_group grid = cg::this_grid();
    const int tid = threadIdx.x, lane = tid & 63, wave = __builtin_amdgcn_readfirstlane(tid >> 6);
    const int G = gridDim.x, bx = blockIdx.x;
    const int gw = bx * NWAVES + wave, NGW = G * NWAVES;
    const int lo = args.ph_lo, hi_ph = args.ph_hi;
    unsigned char* ws = args.ws;
    const float* x = args.in[0]; const float* g_pre_mix = args.in[1]; const float* g_post_mix = args.in[2]; const float* g_pre_ffn = args.in[3]; const float* g_post_ffn = args.in[4];
    const float* w_in = args.in[5]; const float* g_sb = args.in[6]; const float* g_dil = args.in[7]; const float* w_out = args.in[8]; const float* w_up = args.in[9];
    const float* conv_w = args.in[10]; const float* conv_b = args.in[11]; const float* w_down = args.in[12];
    float* out = args.out;
    bf16_t* Win_t = (bf16_t*)(ws + WS_WIN); bf16_t* Wout_t = (bf16_t*)(ws + WS_WOUT); bf16_t* Wup_t = (bf16_t*)(ws + WS_WUP); bf16_t* Wdown_t = (bf16_t*)(ws + WS_WDOWN);
    bf16_t* XN = (bf16_t*)(ws + WS_XN); bf16_t* QKV = (bf16_t*)(ws + WS_QKV); bf16_t* MIXED = (bf16_t*)(ws + WS_MIXED); bf16_t* MIXOUT = (bf16_t*)(ws + WS_MIXOUT);
    bf16_t* OB0 = (bf16_t*)(ws + WS_OB0); bf16_t* OB1 = (bf16_t*)(ws + WS_OB1); bf16_t* OB2 = (bf16_t*)(ws + WS_OB2); float* LSE = (float*)(ws + WS_LSE);
    float* HALO = (float*)(ws + WS_HALO); unsigned* FLAGS = (unsigned*)(ws + WS_FLAGS); bf16_t* Y = (bf16_t*)(ws + WS_Y); float* RSTD1 = (float*)(ws + WS_RSTD1); bf16_t* F = (bf16_t*)(ws + WS_XN); float* ROPE = (float*)(ws + WS_ROPE);
    volatile LAS unsigned* bar_st = (volatile LAS unsigned*)(lds + XCH_OFF + 8192);
    if (tid < 2) bar_st[tid] = 0u;
    __syncthreads();
    unsigned* BAR = (unsigned*)(ws + WS_BAR);
    XcdBarrier xbar = xcd_barrier_post(BAR, bar_st);
    if (args.ph_hi > 1000) grid.sync();
#define IN(k) (lo <= (k) && (k) < hi_ph)
#define SEAM(k) do { if (IN(k) && IN((k) + 1)) xcd_barrier(xbar); } while (0)

    for (int rep_ = 0; rep_ < DUP_P0; ++rep_) if (IN(0)) {
        LAS float* scr = (LAS float*)(lds + wave * 16384);
        constexpr int I_IN = (D / 64) * (NQKV / 32), I_OUT = (D / 64) * (D / 32), I_UP = (D / 64) * (NUP / 32), I_DN = (DFF / 64) * (D / 32);
        constexpr int NITEMS = I_IN + I_OUT + I_UP; (void)I_DN;
        for (int it = gw; it < NITEMS; it += NGW) {
            int r = it;
            if (r < I_IN) { p0_transpose_item<1>(w_in, D, NQKV, Win_t, scr, r, lane); continue; } r -= I_IN;
            if (r < I_OUT) { p0_transpose_item<0>(w_out, D, D, Wout_t, scr, r, lane); continue; } r -= I_OUT;
            p0_transpose_item<2>(w_up, D, NUP, Wup_t, scr, r, lane);
        }
        for (int e = bx * NTHREADS + tid; e < SEQ * 64; e += G * NTHREADS) { const int pos = e >> 6, i = e & 63;
            const float inv_freq = exp2f(-(float)i * (13.287712379549449f / 64.f));
            const float ang = (float)pos * inv_freq; float rev = ang * 0.15915494309189535f; rev = rev - floorf(rev);
            ROPE[2 * e] = __builtin_amdgcn_cosf(rev); ROPE[2 * e + 1] = __builtin_amdgcn_sinf(rev); }
        for (int m = gw; m < M; m += NGW) rms_row_to_bf16(x + (size_t)m * D, g_pre_mix, XN + (size_t)m * D, lane);
    }
    SEAM(0);
    if (IN(1)) {
        pg8::Gemm g{XN, Win_t, M, NQKV, D}; pg8::StaticOrder S; S.init(M, NQKV, G, bx);
        pg8::EpiQKV E{QKV, ROPE, C2};
        pg8::gemm_phase<pg8::EpiQKV, pg8::StaticOrder, true, true>(lds, g, S, E);
    }
#if DUP_P1 > 1
    if (IN(1)) {
        pg8::Gemm g{XN, Win_t, M, NQKV, D}; pg8::StaticOrder S; S.init(M, NQKV, G, bx);
        pg8::EpiQKV E{QKV, ROPE, C2};
        pg8::gemm_phase<pg8::EpiQKV, pg8::StaticOrder, true, true>(lds, g, S, E);
    }
#endif
    SEAM(1);
    if (IN(2)) {
        const int vcu = (G % 8 == 0) ? (bx % 8) * (G / 8) + bx / 8 : bx;
        for (int p = vcu; p < 256; p += G) { const int bh = p >> 2, s = p & 3, b = bh >> 3, h = bh & 7;
            for (int k = 0; k < 2; ++k) { const int qb = k ? 7 - s : s;
                att::attn_unit<0>(lds, QKV, b * SEQ, 1, 0, 1 << 20, 4 * qb + 4, 256 * qb + 192, -64, 0, 256 * qb + 32 * wave, h * HD, 1024 + h * HD, 2048 + h * HD, MIXED, D, h * HD, g_sb, nullptr); } }
        for (int p = vcu; p < 256; p += G) { const int bh = p >> 2, b = bh >> 3, h = bh & 7;
            for (int k = 0; k < 6; ++k) { const int u = (k >> 1) * 8 + (p & 3) * 2 + (k & 1); const int qc = 3072 + h * HD, kc = 4096 + h * HD, vc = 5120 + h * HD;
                if (u < 8) { const int np = u; const int ks0 = np == 0 ? 0 : 256 * np - 128; const int nt = np == 0 ? 4 : 6;
                    att::attn_unit<1>(lds, QKV, b * SEQ, 1, 0, 1 << 20, nt, ks0, 64, 0, 256 * np + 32 * wave, qc, kc, vc, OB0, 1024, h * HD, nullptr, LSE); }
                else if (u < 16) { const int res = (u - 8) >> 1, np = (u - 8) & 1; const int ks0 = np == 0 ? 0 : 128; const int nt = np == 0 ? 4 : 6;
                    att::attn_unit<1>(lds, QKV, b * SEQ, 4, res, 1 << 20, nt, ks0, 64, res, 256 * np + 32 * wave, qc, kc, vc, OB1, 1024, h * HD, nullptr, LSE + (size_t)M * 8); }
                else { const int rp = u - 16;
                    att::attn_unit<1>(lds, QKV, b * SEQ, 16, 2 * rp, 2, 4, 0, 64, 2 * rp + (wave >> 2), 32 * (wave & 3), qc, kc, vc, OB2, 1024, h * HD, nullptr, LSE + (size_t)2 * M * 8); }
            } }
    }
    SEAM(2);
    if (IN(3)) {
        for (int m = gw; m < M; m += NGW) { const int hh = lane >> 3;
            const float l0 = LSE[(size_t)m * 8 + hh], l1 = LSE[(size_t)(M + m) * 8 + hh], l2 = LSE[(size_t)(2 * M + m) * 8 + hh];
            const float mx = fmaxf(l0, fmaxf(l1, l2)); float w0 = __builtin_amdgcn_exp2f(l0 - mx), w1 = __builtin_amdgcn_exp2f(l1 - mx), w2 = __builtin_amdgcn_exp2f(l2 - mx);
            const float wi = 1.f / (w0 + w1 + w2); w0 *= wi; w1 *= wi; w2 *= wi;
            float v[16]; float ss = 0.f;
#pragma unroll
            for (int c = 0; c < 2; ++c) { const size_t off = (size_t)m * 1024 + lane * 16 + c * 8;
                const u32x4 a0 = ldntu4((const u32x4*)(OB0 + off)), a1 = ldntu4((const u32x4*)(OB1 + off)), a2 = ldntu4((const u32x4*)(OB2 + off));
#pragma unroll
                for (int j = 0; j < 4; ++j) { v[c * 8 + 2 * j] = w0 * bf_lo(a0[j]) + w1 * bf_lo(a1[j]) + w2 * bf_lo(a2[j]); v[c * 8 + 2 * j + 1] = w0 * bf_hi(a0[j]) + w1 * bf_hi(a1[j]) + w2 * bf_hi(a2[j]); } }
#pragma unroll
            for (int j = 0; j < 16; ++j) ss += v[j] * v[j];
            ss += __shfl_xor(ss, 1); ss += __shfl_xor(ss, 2); ss += __shfl_xor(ss, 4);
            const float rstd = 1.f / sqrtf(ss * (1.f / HD) + RMS_EPS);
#pragma unroll
            for (int c = 0; c < 2; ++c) { const f32x4 ga = *(const f32x4*)(g_dil + lane * 16 + c * 8), gb = *(const f32x4*)(g_dil + lane * 16 + c * 8 + 4);
                u32x4 w; w.x = pk2(v[c * 8] * rstd * ga[0], v[c * 8 + 1] * rstd * ga[1]); w.y = pk2(v[c * 8 + 2] * rstd * ga[2], v[c * 8 + 3] * rstd * ga[3]);
                w.z = pk2(v[c * 8 + 4] * rstd * gb[0], v[c * 8 + 5] * rstd * gb[1]); w.w = pk2(v[c * 8 + 6] * rstd * gb[2], v[c * 8 + 7] * rstd * gb[3]);
                *(u32x4*)(MIXED + (size_t)m * D + 1024 + lane * 16 + c * 8) = w; } }
    }
    SEAM(3);
    if (IN(4)) {
        pg8::Gemm g{MIXED, Wout_t, M, D, D}; pg8::StaticOrder S; S.init(M, D, G, bx);
        pg8::EpiBf16 E{MIXOUT, D};
        pg8::gemm_phase<pg8::EpiBf16, pg8::StaticOrder, true, true>(lds, g, S, E);
    }
    SEAM(4);
    if (IN(5)) {
        for (int m = gw; m < M; m += NGW) {
            const u32x2* mr = (const u32x2*)(MIXOUT + (size_t)m * D) + lane; const f32x4* xr = (const f32x4*)(x + (size_t)m * D) + lane;
            f32x4 v[8]; float s = 0.f;
#pragma unroll
            for (int j = 0; j < 8; ++j) { const u32x2 w = ldntu2(mr + 64 * j); v[j] = (f32x4){bf_lo(w.x), bf_hi(w.x), bf_lo(w.y), bf_hi(w.y)}; s += (v[j][0] * v[j][0] + v[j][1] * v[j][1]) + (v[j][2] * v[j][2] + v[j][3] * v[j][3]); }
            const float rstd = 1.f / sqrtf(wave_sum(s) * (1.f / D) + RMS_EPS);
            float s2 = 0.f; if (lane == 0) RSTD1[m] = rstd;
#pragma unroll
            for (int j = 0; j < 8; ++j) { const f32x4 g = ((const f32x4*)g_post_mix)[lane + 64 * j]; const f32x4 xv = ldnt4(xr + 64 * j);
                v[j] = xv + v[j] * rstd * g; s2 += (v[j][0] * v[j][0] + v[j][1] * v[j][1]) + (v[j][2] * v[j][2] + v[j][3] * v[j][3]); }
            const float rstd2 = 1.f / sqrtf(wave_sum(s2) * (1.f / D) + RMS_EPS);
            u32x2* o8 = (u32x2*)(XN + (size_t)m * D) + lane;
#pragma unroll
            for (int j = 0; j < 8; ++j) { const f32x4 g = ((const f32x4*)g_pre_ffn)[lane + 64 * j]; u32x2 w; w.x = pk2(v[j][0] * rstd2 * g[0], v[j][1] * rstd2 * g[1]); w.y = pk2(v[j][2] * rstd2 * g[2], v[j][3] * rstd2 * g[3]); o8[64 * j] = w; }
        }
    }
    SEAM(5);
    if (IN(6)) {
        pg8::Gemm g{XN, Wup_t, M, NUP, D}; pg8::StaticOrder S; S.init(M, NUP, G, bx);
        pg8::EpiConv E{Y, conv_w, conv_b, HALO, FLAGS, lds + XCH_OFF, NUP / 256};
        pg8::gemm_phase<pg8::EpiConv, pg8::StaticOrder, true, true>(lds, g, S, E);
        { const int nun = (M / 256) * (NUP / 256); const int rem = nun % G; const int first = rem, nw = (G - first) * NWAVES;
          if (bx >= first) { LAS float* scr = (LAS float*)(lds + wave * 16384); constexpr int I_DN2 = (DFF / 64) * (D / 32);
              for (int it = (bx - first) * NWAVES + wave; it < I_DN2; it += nw) p0_transpose_item<0>(w_down, DFF, D, Wdown_t, scr, it, lane); } }
    }
#if DUP_P6 > 1
    if (IN(6)) {
        pg8::Gemm g{XN, Wup_t, M, NUP, D}; pg8::StaticOrder S; S.init(M, NUP, G, bx);
        pg8::EpiConv E{Y, conv_w, conv_b, HALO, FLAGS, lds + XCH_OFF, NUP / 256};
        pg8::gemm_phase<pg8::EpiConv, pg8::StaticOrder, true, true>(lds, g, S, E);
    }
#endif
    SEAM(6);
    if (IN(7)) {
        pg8::Gemm g{Y, Wdown_t, M, D, DFF}; pg8::StaticOrder S; S.init(M, D, G, bx);
        pg8::EpiBf16 E{F, D};
        pg8::gemm_phase<pg8::EpiBf16, pg8::StaticOrder, true, true>(lds, g, S, E);
    }
    SEAM(7);
    if (IN(8)) {
        for (int m = gw; m < M; m += NGW) {
            const u32x2* fr_ = (const u32x2*)(F + (size_t)m * D) + lane; f32x4* orow = (f32x4*)(out + (size_t)m * D) + lane;
            f32x4 v[8]; float s = 0.f;
#pragma unroll
            for (int j = 0; j < 8; ++j) { const u32x2 w = ldntu2(fr_ + 64 * j); v[j] = (f32x4){bf_lo(w.x), bf_hi(w.x), bf_lo(w.y), bf_hi(w.y)}; s += (v[j][0] * v[j][0] + v[j][1] * v[j][1]) + (v[j][2] * v[j][2] + v[j][3] * v[j][3]); }
            const float rstd = 1.f / sqrtf(wave_sum(s) * (1.f / D) + RMS_EPS);
            const float rstd1 = RSTD1[m]; const u32x2* mr = (const u32x2*)(MIXOUT + (size_t)m * D) + lane; const f32x4* xr = (const f32x4*)(x + (size_t)m * D) + lane;
#pragma unroll
            for (int j = 0; j < 8; ++j) { const f32x4 g = ((const f32x4*)g_post_ffn)[lane + 64 * j]; const f32x4 g1 = ((const f32x4*)g_post_mix)[lane + 64 * j];
                const u32x2 w = ldntu2(mr + 64 * j); const f32x4 mo = (f32x4){bf_lo(w.x), bf_hi(w.x), bf_lo(w.y), bf_hi(w.y)};
                const f32x4 x1 = ldnt4(xr + 64 * j) + mo * rstd1 * g1;
                stnt4(orow + 64 * j, x1 + v[j] * rstd * g); }
        }
    }
#undef IN
#undef SEAM
}

extern "C" void kernel_launch(void* const* d_in, const int* in_sizes, int n_in, void* d_out, int out_size, void* d_ws, size_t ws_size, hipStream_t stream) {
    static int grid = 0;
    if (grid == 0) {
        if (n_in != 13 || in_sizes[0] != M * D || out_size != M * D || ws_size < WS_END) { fprintf(stderr, "kernel_launch: unexpected shapes (n_in %d, in0 %d, out %d, ws %zu)\n", n_in, n_in > 0 ? in_sizes[0] : -1, out_size, ws_size); grid = -1; return; }
        int dev = 0, cus = 0, per_cu = 0;
        hipGetDevice(&dev); hipDeviceGetAttribute(&cus, hipDeviceAttributeMultiprocessorCount, dev);
        if (hipFuncSetAttribute((const void*)fwd_kernel, hipFuncAttributeMaxDynamicSharedMemorySize, LDS_BYTES) != hipSuccess) { fprintf(stderr, "kernel_launch: hipFuncSetAttribute failed\n"); grid = -1; return; }
        if (hipOccupancyMaxActiveBlocksPerMultiprocessor(&per_cu, (const void*)fwd_kernel, NTHREADS, LDS_BYTES) != hipSuccess || per_cu < 1) { fprintf(stderr, "kernel_launch: occupancy query says %d\n", per_cu); per_cu = 1; }
        (void)hipGetLastError();
        grid = cus * (per_cu > 1 ? 1 : per_cu);
        if (grid <= 0) grid = 256;
    }
    if (grid < 0) return;
    if (hipMemsetAsync(d_ws, 0, 131072, stream) != hipSuccess) { fprintf(stderr, "kernel_launch: memset failed\n"); return; }
    Args a{};
    for (int i = 0; i < 13; ++i) a.in[i] = (const float*)d_in[i];
    a.out = (float*)d_out; a.ws = (unsigned char*)d_ws;
#if ONE_LAUNCH
    a.ph_lo = 0; a.ph_hi = N_PHASES;
    void* kargs[] = {&a};
    hipError_t e = hipLaunchCooperativeKernel((const void*)fwd_kernel, dim3(grid), dim3(NTHREADS), kargs, LDS_BYTES, stream);
    if (e != hipSuccess) fprintf(stderr, "kernel_launch: cooperative launch failed: %s (grid %d)\n", hipGetErrorString(e), grid);
#else
    for (int ph = 0; ph < N_PHASES; ++ph) { a.ph_lo = ph; a.ph_hi = ph + 1; hipLaunchKernelGGL(fwd_kernel, dim3(grid), dim3(NTHREADS), LDS_BYTES, stream, a); }
#endif
}
```

```cpp
#include <hip/hip_runtime.h>
#include <hip/hip_cooperative_groups.h>
#include <cstdio>
#include <cstdint>
namespace cg = cooperative_groups;
#ifndef ONE_LAUNCH
#define ONE_LAUNCH 1
#endif
namespace pg8 {
#define PG8_LAS __attribute__((address_space(3)))
typedef unsigned short bf16_t;
typedef short bf16x8 __attribute__((ext_vector_type(8)));
typedef float f32x4 __attribute__((ext_vector_type(4)));
typedef unsigned u32x4 __attribute__((ext_vector_type(4)));
constexpr int BM = 256, BK = 64, HALF = 128, HTB = HALF * BK * 2  , STAGE_BYTES = 8 * HTB, NXCD = 8, WGM = 2;

__host__ __device__ __forceinline__ int lds_byte(int r, int c) { const int st = (r >> 4) * 2 + (c >> 5), rr = r & 15, cc = c & 31, ob = rr * 64 + cc * 2; return st * 1024 + (ob ^ (((ob >> 9) & 1) << 5)); }
__host__ __device__ __forceinline__ void stage_rc(int b, int& R, int& C) { const int st = b / 1024, sb = b % 1024, swz = sb ^ (((sb >> 9) & 1) << 5); R = (st >> 1) * 16 + swz / 64; C = (st & 1) * 32 + (swz % 64) / 2; }
__host__ __device__ __forceinline__ int perm32(int rho) { const int n = rho >> 4, i = rho & 15; return 8 * (i >> 2) + 4 * n + (i & 3); }

struct Unit { int pm, pn; };
struct Gemm { const bf16_t* A; const bf16_t* Bt; int M, N, K; };

struct StaticOrder {
    int nM, nN, nwg, G, c;
    __host__ __device__ void init(int M, int N, int G_, int c_) { nM = M / BM; nN = N / BM; nwg = nM * nN; G = G_; c = c_; }
    __host__ __device__ bool next(int i, Unit& u) const {
        const long L = (long)i * G + c; if (L >= nwg) return false;
        int wgid = (int)L; { const int q = nwg / NXCD, r = nwg % NXCD, xcd = wgid % NXCD, off = wgid / NXCD; wgid = (xcd < r ? xcd * (q + 1) : r * (q + 1) + (xcd - r) * q) + off; }
        const int nig = WGM * nN, gid = wgid / nig, fm = gid * WGM, gsz = (nM - fm) < WGM ? (nM - fm) : WGM;
        u.pm = fm + ((wgid % nig) % gsz); u.pn = (wgid % nig) / gsz; return true;
    }
    __device__ __forceinline__ void a_ready(const Unit&) const {}
    __device__ __forceinline__ void done(const Unit&) const {}
};

__device__ __forceinline__ unsigned cvt_pk_bf16(float lo, float hi) { unsigned r; asm volatile("v_cvt_pk_bf16_f32 %0, %1, %2" : "=v"(r) : "v"(lo), "v"(hi)); return r; }
struct EpiBf16 {
    static constexpr bool PERM = true, AFTER_DRAIN = false;
    bf16_t* O; int ldc;
    __device__ __forceinline__ void operator()(const f32x4 (&acc)[2][2][4][2], const Unit& u, int wr, int wc, int fr, int fq) const {
        const int row0 = u.pm * BM + wr * 64 + fr; const int col0 = u.pn * BM + wc * 32 + 8 * fq;
#pragma unroll
        for (int ai = 0; ai < 2; ++ai)
#pragma unroll
            for (int m = 0; m < 4; ++m) { bf16_t* rowp = O + (size_t)(row0 + ai * HALF + m * 16) * ldc + col0;
#pragma unroll
                for (int bj = 0; bj < 2; ++bj) { const f32x4 v0 = acc[ai][bj][m][0], v1 = acc[ai][bj][m][1];
                    u32x4 w; w.x = cvt_pk_bf16(v0[0], v0[1]); w.y = cvt_pk_bf16(v0[2], v0[3]); w.z = cvt_pk_bf16(v1[0], v1[1]); w.w = cvt_pk_bf16(v1[2], v1[3]);
                    *(u32x4*)(rowp + bj * HALF) = w; } }
    }
};
struct EpiQKV {
    static constexpr bool PERM = true, AFTER_DRAIN = false;
    bf16_t* O; const float* rope; float c2;
    __device__ __forceinline__ void operator()(const f32x4 (&acc)[2][2][4][2], const Unit& u, int wr, int wc, int fr, int fq) const {
        const int row0 = u.pm * BM + wr * 64 + fr; const int col0 = u.pn * BM + wc * 32 + 8 * fq;
        const int seg = u.pn >> 2; const float sc = (seg == 0 || seg == 3) ? c2 : 1.f; const bool rot = (seg == 3 || seg == 4);
#pragma unroll
        for (int ai = 0; ai < 2; ++ai)
#pragma unroll
            for (int m = 0; m < 4; ++m) { const int row = row0 + ai * HALF + m * 16; bf16_t* rowp = O + (size_t)row * 6144 + col0; const int pos = row & 2047;
#pragma unroll
                for (int bj = 0; bj < 2; ++bj) { f32x4 v0 = acc[ai][bj][m][0], v1 = acc[ai][bj][m][1];
                    if (rot) { const int dp = ((col0 + bj * HALF) & 127) >> 1; const f32x4* tp = (const f32x4*)(rope + ((size_t)pos * 64 + dp) * 2);
                        const f32x4 t0 = tp[0], t1 = tp[1];
                        v0 = (f32x4){v0[0] * t0[0] - v0[1] * t0[1], v0[1] * t0[0] + v0[0] * t0[1], v0[2] * t0[2] - v0[3] * t0[3], v0[3] * t0[2] + v0[2] * t0[3]};
                        v1 = (f32x4){v1[0] * t1[0] - v1[1] * t1[1], v1[1] * t1[0] + v1[0] * t1[1], v1[2] * t1[2] - v1[3] * t1[3], v1[3] * t1[2] + v1[2] * t1[3]}; }
                    v0 = v0 * sc; v1 = v1 * sc;
                    u32x4 w; w.x = cvt_pk_bf16(v0[0], v0[1]); w.y = cvt_pk_bf16(v0[2], v0[3]); w.z = cvt_pk_bf16(v1[0], v1[1]); w.w = cvt_pk_bf16(v1[2], v1[3]);
                    *(u32x4*)(rowp + bj * HALF) = w; } }
    }
};

typedef unsigned u32x2 __attribute__((ext_vector_type(2)));

template <int CTRL> __device__ __forceinline__ float dppf(float x) { return __builtin_bit_cast(float, __builtin_amdgcn_update_dpp(0, __builtin_bit_cast(int, x), CTRL, 0xf, 0xf, false)); }
template <int CTRL> __device__ __forceinline__ f32x4 dpp4(f32x4 v) { return (f32x4){dppf<CTRL>(v[0]), dppf<CTRL>(v[1]), dppf<CTRL>(v[2]), dppf<CTRL>(v[3])}; }
__device__ __forceinline__ float gelu_tanh_f(float x) { const float t = x * (1.f + 0.044715f * x * x) * 2.3022081983f; return x * __builtin_amdgcn_rcpf(1.f + __builtin_amdgcn_exp2f(-t)); }
__device__ __forceinline__ f32x4 ldh(const float* p) {
    const unsigned long long a = __hip_atomic_load((const unsigned long long*)p, __ATOMIC_RELAXED, __HIP_MEMORY_SCOPE_AGENT), b = __hip_atomic_load((const unsigned long long*)p + 1, __ATOMIC_RELAXED, __HIP_MEMORY_SCOPE_AGENT);
    return (f32x4){__builtin_bit_cast(float, (unsigned)a), __builtin_bit_cast(float, (unsigned)(a >> 32)), __builtin_bit_cast(float, (unsigned)b), __builtin_bit_cast(float, (unsigned)(b >> 32))}; }
template <int CTRL> __device__ __forceinline__ float dppo(float old, float x) { return __builtin_bit_cast(float, __builtin_amdgcn_update_dpp(__builtin_bit_cast(int, old), __builtin_bit_cast(int, x), CTRL, 0xf, 0xf, false)); }
template <int CTRL> __device__ __forceinline__ f32x4 dppo4(f32x4 o, f32x4 v) { return (f32x4){dppo<CTRL>(o[0], v[0]), dppo<CTRL>(o[1], v[1]), dppo<CTRL>(o[2], v[2]), dppo<CTRL>(o[3], v[3])}; }
struct EpiConv {
    static constexpr bool PERM = true, AFTER_DRAIN = false;
    bf16_t* Y; const float* cw; const float* cb; float* halo; unsigned* flags; PG8_LAS unsigned char* xch; int nN;
    __device__ __forceinline__ void operator()(const f32x4 (&acc)[2][2][4][2], const Unit& u, int wr, int wc, int fr, int fq) const {
        constexpr int NUPc = 11008, DFFc = 5504;
        const int lane = fq * 16 + fr;
        const bool need_prev = (u.pm & 7) != 0;
        if (fr >= 14) {
#pragma unroll
            for (int ai = 0; ai < 2; ++ai)
#pragma unroll
                for (int bj = 0; bj < 2; ++bj)
#pragma unroll
                    for (int n = 0; n < 2; ++n) *(PG8_LAS f32x4*)(xch + ((((ai * 2 + wr) * 4 + wc) * 2 + (fr - 14)) * 64 + bj * 32 + 8 * fq + 4 * n) * 4) = acc[ai][bj][3][n];
            if (wr == 1) { float* hp = halo + ((size_t)(u.pm * nN + u.pn) * 2 + (fr - 14)) * 256 + wc * 32 + 8 * fq;
#pragma unroll
                for (int bj = 0; bj < 2; ++bj)
#pragma unroll
                    for (int n = 0; n < 2; ++n) { const f32x4 v = acc[1][bj][3][n]; unsigned long long* q = (unsigned long long*)(hp + bj * 128 + 4 * n);
                        const float e0 = v[0], e1 = v[1], e2 = v[2], e3 = v[3];
                        __hip_atomic_store(q, ((unsigned long long)__float_as_uint(e1) << 32) | __float_as_uint(e0), __ATOMIC_RELAXED, __HIP_MEMORY_SCOPE_AGENT);
                        __hip_atomic_store(q + 1, ((unsigned long long)__float_as_uint(e3) << 32) | __float_as_uint(e2), __ATOMIC_RELAXED, __HIP_MEMORY_SCOPE_AGENT); } }
        }
        if (wr == 1) { asm volatile("s_waitcnt vmcnt(0)" ::: "memory"); if (lane == 0) __hip_atomic_fetch_add(flags + u.pm * nN + u.pn, 1u, __ATOMIC_RELAXED, __HIP_MEMORY_SCOPE_AGENT); }
        if (need_prev && wr == 0 && wc == 0) {
            const unsigned* fp = flags + (u.pm - 1) * nN + u.pn;
            for (unsigned sp_ = 0; (unsigned)__builtin_amdgcn_readfirstlane(__hip_atomic_load(fp, __ATOMIC_RELAXED, __HIP_MEMORY_SCOPE_AGENT)) < 4u && sp_ < (1u << 22); ++sp_) __builtin_amdgcn_s_sleep(2);
            __builtin_amdgcn_fence(__ATOMIC_ACQUIRE, "agent");
            asm volatile("s_waitcnt vmcnt(0)" ::: "memory");
        }
        asm volatile("s_waitcnt lgkmcnt(0)" ::: "memory"); __builtin_amdgcn_s_barrier(); asm volatile("" ::: "memory");
        u32x2 ypk[2][4];
#pragma unroll
        for (int n = 0; n < 2; ++n) {
            const int fcol = u.pn * 128 + wc * 32 + 8 * fq + 4 * n;
            f32x4 wg[3], wv[3];
#pragma unroll
            for (int j = 0; j < 3; ++j) { wg[j] = *(const f32x4*)(cw + (size_t)j * NUPc + fcol); wv[j] = *(const f32x4*)(cw + (size_t)j * NUPc + DFFc + fcol); }
            const f32x4 bg = *(const f32x4*)(cb + fcol), bv = *(const f32x4*)(cb + DFFc + fcol);
#pragma unroll
            for (int ai = 0; ai < 2; ++ai) {
                f32x4 h1g, h2g, h1v, h2v;
                const int ci = 2 * ai + wr;
                if (ci == 0) {
                    if (need_prev) { const float* hp = halo + ((size_t)((u.pm - 1) * nN + u.pn) * 2) * 256 + wc * 32 + 8 * fq + 4 * n;
                        h2g = ldh(hp); h2v = ldh(hp + 128); h1g = ldh(hp + 256); h1v = ldh(hp + 256 + 128); }
                    else { h1g = h2g = h1v = h2v = (f32x4){0.f, 0.f, 0.f, 0.f}; }
                } else { const int cp = ci - 1; const PG8_LAS unsigned char* xp = xch + ((((cp >> 1) * 2 + (cp & 1)) * 4 + wc) * 2 * 64 + 8 * fq + 4 * n) * 4;
                    h2g = *(const PG8_LAS f32x4*)(xp); h2v = *(const PG8_LAS f32x4*)(xp + 32 * 4); h1g = *(const PG8_LAS f32x4*)(xp + 64 * 4); h1v = *(const PG8_LAS f32x4*)(xp + 64 * 4 + 32 * 4); }
                f32x4 og1 = h1g, ov1 = h1v, og2, ov2;
#pragma unroll
                for (int e = 0; e < 4; ++e) { og2[e] = fr == 1 ? h1g[e] : h2g[e]; ov2[e] = fr == 1 ? h1v[e] : h2v[e]; }
#pragma unroll
                for (int m = 0; m < 4; ++m) {
                    const f32x4 g0 = acc[ai][0][m][n], v0 = acc[ai][1][m][n];
                    const f32x4 g1 = dppo4<0x111>(og1, g0), g2 = dppo4<0x112>(og2, g0), v1 = dppo4<0x111>(ov1, v0), v2 = dppo4<0x112>(ov2, v0);
                    if (m < 3) { og1 = dpp4<0x121>(g0); og2 = dpp4<0x122>(g0); ov1 = dpp4<0x121>(v0); ov2 = dpp4<0x122>(v0); }
                    const f32x4 gt = bg + wg[0] * g2 + wg[1] * g1 + wg[2] * g0, vl = bv + wv[0] * v2 + wv[1] * v1 + wv[2] * v0;
                    u32x2 w; w.x = cvt_pk_bf16(gelu_tanh_f(gt[0]) * vl[0], gelu_tanh_f(gt[1]) * vl[1]); w.y = cvt_pk_bf16(gelu_tanh_f(gt[2]) * vl[2], gelu_tanh_f(gt[3]) * vl[3]);
                    if (n == 0) ypk[ai][m] = w;
                    else { u32x4 o; o.x = ypk[ai][m].x; o.y = ypk[ai][m].y; o.z = w.x; o.w = w.y;
                        *(u32x4*)(Y + (size_t)(u.pm * BM + ai * HALF + wr * 64 + m * 16 + fr) * DFFc + u.pn * 128 + wc * 32 + 8 * fq) = o; }
                }
            }
        }
    }
};
template <class Epi, class Sched, bool ALIGN_EPI = false, bool SP2 = false>
__device__ __forceinline__ void gemm_phase(PG8_LAS unsigned char* lds, const Gemm g, const Sched& S, const Epi& E) {
    const int tid = threadIdx.x, wid = __builtin_amdgcn_readfirstlane(tid >> 6), lane = tid & 63, wr = wid >> 2, wc = wid & 3, fr = lane & 15, fq = lane >> 4;
    const int K = g.K, nt = K / BK;
    unsigned voffA[2], voffB[2];
#pragma unroll
    for (int i = 0; i < 2; ++i) { int R, C; stage_rc(tid * 16 + i * 8192, R, C); const int Rb = Epi::PERM ? ((R & ~31) + perm32(R & 31)) : R;
        voffA[i] = (unsigned)(R * K + C) * 2u; voffB[i] = (unsigned)(Rb * K + C) * 2u; }
    const size_t kstep = (size_t)(BK * 2);
    const size_t hstep = (size_t)HALF * K * 2;
    const size_t tstep = 2 * hstep;
    const unsigned ldsw = (unsigned)wid * 1024u;
    const int aoff = lds_byte(wr * 64 + fr, fq * 8), boff = lds_byte(wc * 32 + fr, fq * 8);
#define PG8_SA(b, h) (((b) * 2 + (h)) * HTB)
#define PG8_SB(b, h) ((4 + (b) * 2 + (h)) * HTB)
#define PG8_STAGE(bufoff, gbase, voff) do { _Pragma("unroll") for (int _i = 0; _i < 2; ++_i) \
        __builtin_amdgcn_global_load_lds((const unsigned*)((const char*)(gbase) + (voff)[_i]), (PG8_LAS unsigned*)(lds + (bufoff) + ldsw + _i * 8192), 16, 0, 0); } while (0)
#define PG8_LDA(dst, b, h) do { _Pragma("unroll") for (int m = 0; m < 4; ++m) _Pragma("unroll") for (int k = 0; k < 2; ++k) dst[m][k] = *(const PG8_LAS bf16x8*)(lds + PG8_SA(b, h) + aoff + m * 2048 + k * 1024); } while (0)
#define PG8_LDB(dst, b, h) do { _Pragma("unroll") for (int n = 0; n < 2; ++n) _Pragma("unroll") for (int k = 0; k < 2; ++k) dst[n][k] = *(const PG8_LAS bf16x8*)(lds + PG8_SB(b, h) + boff + n * 2048 + k * 1024); } while (0)
#define PG8_MMA(ai, bj, At, Bt) do { __builtin_amdgcn_s_setprio(1); _Pragma("unroll") for (int m = 0; m < 4; ++m) _Pragma("unroll") for (int n = 0; n < 2; ++n) _Pragma("unroll") for (int k = 0; k < 2; ++k) \
        acc[ai][bj][m][n] = __builtin_amdgcn_mfma_f32_16x16x32_bf16(Bt[n][k], At[m][k], acc[ai][bj][m][n], 0, 0, 0); __builtin_amdgcn_s_setprio(0); } while (0)
#define PG8_WAIT_V(n) asm volatile("s_waitcnt vmcnt(" #n ")" ::: "memory")
#define PG8_WAIT_L(n) asm volatile("s_waitcnt lgkmcnt(" #n ")" ::: "memory")
#define PG8_BAR __builtin_amdgcn_s_barrier()
#define PG8_SCHED __builtin_amdgcn_sched_barrier(0)
    Unit cur, nxt; int ui = 0;
    if (!S.next(0, cur)) return;
    f32x4 acc[2][2][4][2];
#pragma unroll
    for (int a = 0; a < 2; ++a)
#pragma unroll
        for (int b = 0; b < 2; ++b)
#pragma unroll
            for (int m = 0; m < 4; ++m)
#pragma unroll
                for (int n = 0; n < 2; ++n) acc[a][b][m][n] = (f32x4){0.f, 0.f, 0.f, 0.f};
    bf16x8 At[4][2], B0[2][2], B1[2][2];
    const char* cA = (const char*)g.A + (size_t)cur.pm * tstep; const char* cB = (const char*)g.Bt + (size_t)cur.pn * tstep;
    S.a_ready(cur);
    if constexpr (SP2) {
        PG8_STAGE(PG8_SB(0, 0), cB, voffB); PG8_STAGE(PG8_SB(0, 1), cB + hstep, voffB); PG8_STAGE(PG8_SA(0, 0), cA, voffA); PG8_STAGE(PG8_SA(0, 1), cA + hstep, voffA);
        if (wr == 1) PG8_BAR;
        PG8_WAIT_V(2); PG8_BAR;
        PG8_STAGE(PG8_SB(1, 0), cB + kstep, voffB); PG8_STAGE(PG8_SA(1, 0), cA + kstep, voffA); PG8_STAGE(PG8_SB(1, 1), cB + hstep + kstep, voffB);
        PG8_WAIT_V(6); PG8_BAR;
    } else {
        PG8_STAGE(PG8_SB(0, 0), cB, voffB); PG8_STAGE(PG8_SA(0, 0), cA, voffA); PG8_STAGE(PG8_SB(0, 1), cB + hstep, voffB); PG8_STAGE(PG8_SA(0, 1), cA + hstep, voffA);
        if (wr == 1) PG8_BAR;
        PG8_WAIT_V(4); PG8_BAR;
        PG8_STAGE(PG8_SB(1, 0), cB + kstep, voffB); PG8_STAGE(PG8_SA(1, 0), cA + kstep, voffA); PG8_STAGE(PG8_SB(1, 1), cB + hstep + kstep, voffB);
        PG8_WAIT_V(6); PG8_BAR;
    }
    for (;;) {
        const bool has_next = S.next(ui + 1, nxt);
        const char* nA = has_next ? (const char*)g.A + (size_t)nxt.pm * tstep : cA; const char* nB = has_next ? (const char*)g.Bt + (size_t)nxt.pn * tstep : cB;
        for (int t = 0; t < nt; t += 2) {
            const bool last = (t == nt - 2);
            const char* a1 = cA + (size_t)(t + 1) * kstep;
            const char* a2 = last ? nA : cA + (size_t)(t + 2) * kstep; const char* b2 = last ? nB : cB + (size_t)(t + 2) * kstep;
            const char* a3 = a2 + kstep; const char* b3 = b2 + kstep;
            if (last && has_next) S.a_ready(nxt);
            if constexpr (SP2) {
            PG8_LDB(B0, 0, 0); PG8_LDB(B1, 0, 1); PG8_SCHED; PG8_LDA(At, 0, 0); PG8_STAGE(PG8_SA(1, 1), a1 + hstep, voffA);
            PG8_WAIT_V(8); PG8_WAIT_L(0); PG8_BAR; PG8_MMA(0, 0, At, B0); PG8_MMA(0, 1, At, B1); PG8_BAR; PG8_SCHED;
            PG8_LDA(At, 0, 1); PG8_STAGE(PG8_SB(0, 0), b2, voffB); PG8_STAGE(PG8_SB(0, 1), b2 + hstep, voffB); PG8_STAGE(PG8_SA(0, 0), a2, voffA);
            PG8_WAIT_V(8); PG8_WAIT_L(0); PG8_BAR; PG8_MMA(1, 0, At, B0); PG8_MMA(1, 1, At, B1); PG8_BAR; PG8_SCHED;
            PG8_LDB(B0, 1, 0); PG8_LDB(B1, 1, 1); PG8_SCHED; PG8_LDA(At, 1, 0); PG8_STAGE(PG8_SA(0, 1), a2 + hstep, voffA);
            PG8_WAIT_V(8); PG8_WAIT_L(0); PG8_BAR; PG8_MMA(0, 0, At, B0); PG8_MMA(0, 1, At, B1); PG8_BAR; PG8_SCHED;
            PG8_LDA(At, 1, 1); PG8_STAGE(PG8_SB(1, 0), b3, voffB); PG8_STAGE(PG8_SB(1, 1), b3 + hstep, voffB); PG8_STAGE(PG8_SA(1, 0), a3, voffA);
            PG8_WAIT_V(8); PG8_WAIT_L(0); PG8_BAR; PG8_MMA(1, 0, At, B0); PG8_MMA(1, 1, At, B1); PG8_BAR; PG8_SCHED;
            } else {
            PG8_LDB(B0, 0, 0); PG8_SCHED; PG8_LDA(At, 0, 0); PG8_STAGE(PG8_SA(1, 1), a1 + hstep, voffA);
            PG8_WAIT_L(8); PG8_BAR; PG8_WAIT_L(0); PG8_MMA(0, 0, At, B0); PG8_BAR; PG8_SCHED;
            PG8_LDB(B1, 0, 1); PG8_STAGE(PG8_SB(0, 0), b2, voffB);
            PG8_BAR; PG8_WAIT_L(0); PG8_MMA(0, 1, At, B1); PG8_BAR;
            PG8_LDA(At, 0, 1); PG8_STAGE(PG8_SA(0, 0), a2, voffA);
            PG8_BAR; PG8_WAIT_L(0); PG8_MMA(1, 0, At, B0); PG8_BAR; PG8_SCHED;
            PG8_STAGE(PG8_SB(0, 1), b2 + hstep, voffB);
            PG8_WAIT_V(6); PG8_BAR; PG8_MMA(1, 1, At, B1); PG8_BAR;
            PG8_LDB(B0, 1, 0); PG8_SCHED; PG8_LDA(At, 1, 0); PG8_STAGE(PG8_SA(0, 1), a2 + hstep, voffA);
            PG8_WAIT_L(8); PG8_BAR; PG8_WAIT_L(0); PG8_MMA(0, 0, At, B0); PG8_BAR; PG8_SCHED;
            PG8_LDB(B1, 1, 1); PG8_STAGE(PG8_SB(1, 0), b3, voffB);
            PG8_BAR; PG8_WAIT_L(0); PG8_MMA(0, 1, At, B1); PG8_BAR;
            PG8_LDA(At, 1, 1); PG8_STAGE(PG8_SA(1, 0), a3, voffA);
            PG8_BAR; PG8_WAIT_L(0); PG8_MMA(1, 0, At, B0); PG8_BAR; PG8_SCHED;
            PG8_STAGE(PG8_SB(1, 1), b3 + hstep, voffB);
            PG8_WAIT_V(6); PG8_BAR; PG8_MMA(1, 1, At, B1); PG8_BAR;
            }
        }
        if constexpr (ALIGN_EPI) { if (wr == 0) PG8_BAR; }
        if constexpr (!Epi::AFTER_DRAIN) { E(acc, cur, wr, wc, fr, fq); S.done(cur); }
        if (!has_next) break;
#pragma unroll
        for (int a = 0; a < 2; ++a)
#pragma unroll
            for (int b = 0; b < 2; ++b)
#pragma unroll
                for (int m = 0; m < 4; ++m)
#pragma unroll
                    for (int n = 0; n < 2; ++n) acc[a][b][m][n] = (f32x4){0.f, 0.f, 0.f, 0.f};
        cur = nxt; cA = nA; cB = nB; ++ui;
        if constexpr (ALIGN_EPI) { if (wr == 1) PG8_BAR; }
    }
    PG8_WAIT_V(0);
    if constexpr (!ALIGN_EPI) { if (wr == 0) PG8_BAR; }
    PG8_BAR;
    if constexpr (Epi::AFTER_DRAIN) { E.fused(acc, cur, wr, wc, fr, fq, lds, wid, lane); S.done(cur); }
#undef PG8_SA
#undef PG8_SB
#undef PG8_STAGE
#undef PG8_LDA
#undef PG8_LDB
#undef PG8_MMA
#undef PG8_WAIT_V
#undef PG8_WAIT_L
#undef PG8_BAR
#undef PG8_SCHED
}
}
using pg8::bf16_t; using pg8::bf16x8; using pg8::f32x4; using pg8::u32x4;
#define LAS __attribute__((address_space(3)))
typedef float f32x16 __attribute__((ext_vector_type(16)));
using pg8::u32x2;
typedef short s16x4 __attribute__((ext_vector_type(4)));

constexpr int SEQ = 2048, BATCH = 8, M = BATCH * SEQ, D = 2048, NQKV = 6144, DFF = 5504, NUP = 2 * DFF, HD = 128;
constexpr float RMS_EPS = 1e-6f;
constexpr float C2 = 0.08838834764831845f * 1.4426950408889634f;
constexpr int NWAVES = 8, NTHREADS = 512;
constexpr int MHALF = M / 2;
constexpr size_t MiB = 1u << 20;
constexpr size_t WS_ROPE = 1 * MiB;
constexpr size_t WS_WIN = 2 * MiB, WS_WOUT = 26 * MiB, WS_WUP = 34 * MiB, WS_WDOWN = 77 * MiB;
constexpr size_t WS_XN = 100 * MiB;
constexpr size_t WS_OB2 = 100 * MiB, WS_LSE = 132 * MiB;
constexpr size_t WS_QKV = 164 * MiB;
constexpr size_t WS_MIXED = 356 * MiB;
constexpr size_t WS_MIXOUT = 420 * MiB;
constexpr size_t WS_OB0 = 420 * MiB, WS_OB1 = 452 * MiB;
constexpr size_t WS_Y = 164 * MiB;
constexpr size_t WS_HALO = 340 * MiB;
constexpr size_t WS_BAR = 65536;
constexpr size_t WS_RSTD1 = 348 * MiB;
constexpr size_t WS_FLAGS = 0;
constexpr size_t WS_END = 484 * MiB;
constexpr int RING_BYTES = 131072, XCH_OFF = RING_BYTES, LDS_BYTES = RING_BYTES + 8192 + 4096;

__device__ __forceinline__ u32x4 ldntu4(const u32x4* p) { return __builtin_nontemporal_load(p); }
__device__ __forceinline__ u32x2 ldntu2(const u32x2* p) { return __builtin_nontemporal_load(p); }
__device__ __forceinline__ f32x4 ldnt4(const f32x4* p) { return __builtin_nontemporal_load(p); }
__device__ __forceinline__ void stnt4(f32x4* p, f32x4 v) { __builtin_nontemporal_store(v, p); }
__device__ __forceinline__ float wave_sum(float v) {
#pragma unroll
    for (int o = 1; o < 64; o <<= 1) v += __shfl_xor(v, o);
    return v;
}
__device__ __forceinline__ unsigned f2bf(float f) { unsigned u = __builtin_bit_cast(unsigned, f); return (u + 0x7fffu + ((u >> 16) & 1u)) >> 16; }
__device__ __forceinline__ unsigned pk2(float lo, float hi) { unsigned r; asm("v_cvt_pk_bf16_f32 %0, %1, %2" : "=v"(r) : "v"(lo), "v"(hi)); return r; }
__device__ __forceinline__ float bf_lo(unsigned w) { return __builtin_bit_cast(float, w << 16); }
__device__ __forceinline__ float bf_hi(unsigned w) { return __builtin_bit_cast(float, w & 0xffff0000u); }

__device__ __forceinline__ int win_rowmap(int n) { const int seg = n >> 10; if (seg == 3 || seg == 4) { const int w = n & 1023, hh = w >> 7, d = w & 127; return (seg << 10) + (hh << 7) + 2 * (d & 63) + (d >> 6); } return n; }
__device__ __forceinline__ int up_rowmap(int n) { const int f = n < DFF ? n : n - DFF; return (f >> 7) * 256 + (n < DFF ? 0 : 128) + (f & 127); }
template <int MAP> __device__ __forceinline__ void p0_transpose_item(const float* __restrict__ W, int K, int N, bf16_t* WT, LAS float* scr, int item, int lane) {
    const int nblk = N / 32, kb = item / nblk, nb = item % nblk, k0 = 64 * kb, n0 = 32 * nb;
#pragma unroll 8
    for (int i = 0; i < 32; ++i) { const int kk = 2 * i + (lane >> 5); scr[kk * 33 + (lane & 31)] = __builtin_nontemporal_load(W + (size_t)(k0 + kk) * N + n0 + (lane & 31)); }
    asm volatile("s_waitcnt lgkmcnt(0)" ::: "memory");
    const int c = lane & 7;
#pragma unroll
    for (int j = 0; j < 4; ++j) { const int n = (lane >> 3) + 8 * j; const LAS float* s = scr + (8 * c) * 33 + n;
        u32x4 o; o.x = pk2(s[0 * 33], s[1 * 33]); o.y = pk2(s[2 * 33], s[3 * 33]); o.z = pk2(s[4 * 33], s[5 * 33]); o.w = pk2(s[6 * 33], s[7 * 33]);
        const int drow = MAP == 1 ? win_rowmap(n0 + n) : (MAP == 2 ? up_rowmap(n0 + n) : (n0 + n));
        *(u32x4*)(WT + (size_t)drow * K + k0 + 8 * c) = o; }
    asm volatile("s_waitcnt lgkmcnt(0)" ::: "memory");
}
__device__ __forceinline__ void rms_row_to_bf16(const float* xrow, const float* gain, bf16_t* orow, int lane) {
    const f32x4* xr = (const f32x4*)xrow + lane; f32x4 v[8]; float s = 0.f;
#pragma unroll
    for (int j = 0; j < 8; ++j) { v[j] = ldnt4(xr + 64 * j); s += (v[j][0] * v[j][0] + v[j][1] * v[j][1]) + (v[j][2] * v[j][2] + v[j][3] * v[j][3]); }
    const float rstd = 1.f / sqrtf(wave_sum(s) * (1.f / D) + RMS_EPS);
    const f32x4* gr = (const f32x4*)gain + lane; u32x2* o8 = (u32x2*)orow + lane;
#pragma unroll
    for (int j = 0; j < 8; ++j) { const f32x4 g = gr[64 * j]; u32x2 w; w.x = pk2(v[j][0] * rstd * g[0], v[j][1] * rstd * g[1]); w.y = pk2(v[j][2] * rstd * g[2], v[j][3] * rstd * g[3]); o8[64 * j] = w; }
}

namespace att {
constexpr int KST = 272, VST = 320, KTB = 64 * KST, VTB = 64 * VST, BUFB = KTB + VTB;
constexpr int PITCH = NQKV;
constexpr float SB_DONE_BITS = 48.f;
__device__ __forceinline__ constexpr int crow(int r, int hi) { return (r & 3) + 8 * (r >> 2) + 4 * hi; }
struct HalfPair { float lo, up; };
__device__ __forceinline__ HalfPair xhalf(float v) { const auto rr = __builtin_amdgcn_permlane32_swap(__float_as_uint(v), __float_as_uint(v), false, false); return HalfPair{__uint_as_float(rr[0]), __uint_as_float(rr[1])}; }
__device__ __forceinline__ float xhalf_sum(float v) { const HalfPair h = xhalf(v); return h.lo + h.up; }
__device__ __forceinline__ float xhalf_max(float v) { const HalfPair h = xhalf(v); return __builtin_fmaxf(h.lo, h.up); }
__device__ __forceinline__ s16x4 vtr(const LAS unsigned char* p) { return __builtin_bit_cast(s16x4, __builtin_amdgcn_ds_read_tr16_b64_v4i16((LAS s16x4*)p)); }

template <int KIND> __device__ __forceinline__ void subblock(const LAS unsigned char* kt, const LAS unsigned char* vt, const bf16x8 (&qf)[8], f32x16 (&o)[4], float& st0, float& st1, const int mask, const int r32, const int hi, const int lane) {
    f32x16 z = {0.f, 0.f, 0.f, 0.f, 0.f, 0.f, 0.f, 0.f, 0.f, 0.f, 0.f, 0.f, 0.f, 0.f, 0.f, 0.f}, z1 = z;
    const LAS unsigned char* kp = kt + r32 * KST + hi * 16;
#pragma unroll
    for (int d0 = 0; d0 < 8; d0 += 2) { const bf16x8 kf = *(const LAS bf16x8*)(kp + d0 * 32), kg = *(const LAS bf16x8*)(kp + d0 * 32 + 32);
        z = __builtin_amdgcn_mfma_f32_32x32x16_bf16(kf, qf[d0], z, 0, 0, 0); z1 = __builtin_amdgcn_mfma_f32_32x32x16_bf16(kg, qf[d0 + 1], z1, 0, 0, 0); }
    z = z + z1;
    float p[16];
    if (KIND == 0) {
        float L[16];
#pragma unroll
        for (int r = 0; r < 16; ++r) { const float zz = __builtin_fminf(z[r], 120.f); const float e = __builtin_amdgcn_exp2f(zz); float l2 = __builtin_amdgcn_logf(1.f + e);
            if (mask == 1 && !(crow(r, hi) < r32)) l2 = 0.f; L[r] = l2; }
        HalfPair gp[4];
#pragma unroll
        for (int i = 0; i < 4; ++i) gp[i] = xhalf((L[4 * i] + L[4 * i + 1]) + (L[4 * i + 2] + L[4 * i + 3]));
        float t[4]; t[3] = 0.f; t[2] = gp[3].lo + gp[3].up; t[1] = t[2] + (gp[2].lo + gp[2].up); t[0] = t[1] + (gp[1].lo + gp[1].up);
        const float T = t[0] + (gp[0].lo + gp[0].up);
#pragma unroll
        for (int i = 0; i < 4; ++i) { const float b = st0 + t[i] + (hi == 0 ? gp[i].up : 0.f);
            const float w3 = b + L[4 * i + 3], w2 = w3 + L[4 * i + 2], w1 = w2 + L[4 * i + 1], w0 = w1 + L[4 * i + 0];
            p[4 * i + 0] = z[4 * i + 0] - w0; p[4 * i + 1] = z[4 * i + 1] - w1; p[4 * i + 2] = z[4 * i + 2] - w2; p[4 * i + 3] = z[4 * i + 3] - w3; }
#pragma unroll
        for (int r = 0; r < 16; ++r) { float a = __builtin_amdgcn_exp2f(p[r]); if (mask == 1 && !(crow(r, hi) < r32)) a = 0.f; p[r] = a; }
        st0 += T;
    } else {
        float rm = -INFINITY;
#pragma unroll
        for (int r = 0; r < 16; ++r) { float zz = z[r]; if (mask == 1 && crow(r, hi) > r32) zz = -INFINITY; if (mask == 2 && crow(r, hi) < r32) zz = -INFINITY; p[r] = zz; rm = __builtin_fmaxf(rm, zz); }
        rm = xhalf_max(rm);
        if (__any(rm > st0 + 8.f)) { const float mn = __builtin_fmaxf(st0, rm); const float alpha = __builtin_amdgcn_exp2f(st0 - mn); st0 = mn; st1 *= alpha;
#pragma unroll
            for (int d0 = 0; d0 < 4; ++d0) o[d0] = o[d0] * alpha; }
        float s = 0.f;
#pragma unroll
        for (int r = 0; r < 16; ++r) { p[r] = __builtin_amdgcn_exp2f(p[r] - st0); s += p[r]; }
        st1 += s;
    }
    u32x4 pw0, pw1;
    pw0.x = pg8::cvt_pk_bf16(p[0], p[1]); pw0.y = pg8::cvt_pk_bf16(p[2], p[3]); pw0.z = pg8::cvt_pk_bf16(p[4], p[5]); pw0.w = pg8::cvt_pk_bf16(p[6], p[7]);
    pw1.x = pg8::cvt_pk_bf16(p[8], p[9]); pw1.y = pg8::cvt_pk_bf16(p[10], p[11]); pw1.z = pg8::cvt_pk_bf16(p[12], p[13]); pw1.w = pg8::cvt_pk_bf16(p[14], p[15]);
    const bf16x8 pa0 = __builtin_bit_cast(bf16x8, pw0), pa1 = __builtin_bit_cast(bf16x8, pw1);
    const LAS unsigned char* vp = vt + (4 * hi + ((lane & 15) >> 2)) * VST + ((lane >> 4) & 1) * 32 + (lane & 3) * 8;
#pragma unroll
    for (int d0 = 0; d0 < 4; ++d0) {
        const s16x4 a0 = vtr(vp + d0 * 64), a1 = vtr(vp + d0 * 64 + 8 * VST), b0 = vtr(vp + d0 * 64 + 16 * VST), b1 = vtr(vp + d0 * 64 + 24 * VST);
        const bf16x8 va = (bf16x8){a0[0], a0[1], a0[2], a0[3], a1[0], a1[1], a1[2], a1[3]}, vb = (bf16x8){b0[0], b0[1], b0[2], b0[3], b1[0], b1[1], b1[2], b1[3]};
        o[d0] = __builtin_amdgcn_mfma_f32_32x32x16_bf16(va, pa0, o[d0], 0, 0, 0);
        o[d0] = __builtin_amdgcn_mfma_f32_32x32x16_bf16(vb, pa1, o[d0], 0, 0, 0);
    }
}

template <int KIND> __device__ __forceinline__ void attn_unit(LAS unsigned char* lds, const bf16_t* __restrict__ QKV, int rb, int dil, int res0, int isplit, int nt, int ks_first, int kstep,
                                                             int res_w, int lw0, int qcol, int kcol, int vcol, bf16_t* Out, int out_pitch, int ocol, const float* gain, float* lse_out) {
    const int tid = threadIdx.x, lane = tid & 63, r32 = lane & 31, hi = lane >> 5;
    const int tq = rb + (lw0 + r32) * dil + res_w;
    bf16x8 qf[8];
    {
      LAS unsigned char* qstg = lds + 40960 + (tid >> 6) * 8704;
#pragma unroll
      for (int hf = 0; hf < 2; ++hf) { u32x4 qrow[4];
#pragma unroll
          for (int it = 0; it < 4; ++it) { const int row = (hf * 4 + it) * 4 + (lane >> 4), ch = lane & 15; const int tok = rb + (lw0 + row) * dil + res_w;
              qrow[it] = *(const u32x4*)(QKV + (size_t)tok * PITCH + qcol + ch * 8); }
#pragma unroll
          for (int it = 0; it < 4; ++it) { const int row = (hf * 4 + it) * 4 + (lane >> 4), ch = lane & 15; *(LAS u32x4*)(qstg + row * 272 + ch * 16) = qrow[it]; } }
      asm volatile("s_waitcnt lgkmcnt(0)" ::: "memory");
#pragma unroll
      for (int d0 = 0; d0 < 8; ++d0) qf[d0] = *(const LAS bf16x8*)(qstg + r32 * 272 + (16 * d0 + 8 * hi) * 2);
      asm volatile("s_waitcnt lgkmcnt(0)" ::: "memory"); }
    f32x16 o[4];
#pragma unroll
    for (int d0 = 0; d0 < 4; ++d0) o[d0] = (f32x16){0.f, 0.f, 0.f, 0.f, 0.f, 0.f, 0.f, 0.f, 0.f, 0.f, 0.f, 0.f, 0.f, 0.f, 0.f, 0.f};
    float st0 = (KIND == 0) ? 0.f : -INFINITY, st1 = 0.f;
    const int srow = tid >> 4, sch = tid & 15;
    u32x4 krA[2], vrA[2];
#define ATT_TILE_GEOM(i, res_i, ks_i) const int sp_ = ((i) >= isplit) ? 1 : 0; const int res_i = res0 + sp_; const int ks_i = ks_first + kstep * ((i) - (sp_ ? isplit : 0));
#define ATT_LOAD(i, KR, VR) do { ATT_TILE_GEOM(i, res_i, ks_i) _Pragma("unroll") for (int c = 0; c < 2; ++c) { const int tok = rb + (ks_i + srow + 32 * c) * dil + res_i; const bf16_t* p = QKV + (size_t)tok * PITCH + sch * 8; \
        KR[c] = *(const u32x4*)(p + kcol); VR[c] = *(const u32x4*)(p + vcol); } } while (0)
#define ATT_STORE(buf, KR, VR) do { _Pragma("unroll") for (int c = 0; c < 2; ++c) { *(LAS u32x4*)(lds + (buf) * BUFB + (srow + 32 * c) * KST + sch * 16) = KR[c]; *(LAS u32x4*)(lds + (buf) * BUFB + KTB + (srow + 32 * c) * VST + sch * 16) = VR[c]; } } while (0)
#define ATT_ITER(i, KRA, VRA, KRB, VRB) do { \
        { const int ip_ = ((i) + 1 < nt) ? (i) + 1 : nt - 1; ATT_LOAD(ip_, KRA, VRA); }     \
        { ATT_TILE_GEOM(i, res_i, ks_i) \
          if (res_i == res_w) { \
            const LAS unsigned char* kb = lds + ((i) & 1) * BUFB; const LAS unsigned char* vb = kb + KTB; \
            _Pragma("unroll") for (int ss = 0; ss < 2; ++ss) { const int sub = (KIND == 0) ? 1 - ss : ss; const int kss = ks_i + 32 * sub; \
                const bool need = (kss <= lw0) && (KIND == 0 || kss >= lw0 - 128); \
                if (need) { const int mask = (kss == lw0) ? 1 : ((KIND == 1 && kss == lw0 - 128) ? 2 : 0); \
                    subblock<KIND>(kb + sub * 32 * KST, vb + sub * 32 * VST, qf, o, st0, st1, mask, r32, hi, lane); } } \
          } } \
        if (KIND == 0) { const int dn_ = __all(st0 > SB_DONE_BITS) ? 1 : 0; if (lane == 0) dflag[((i) & 1) * 8 + wid] = dn_; } \
        ATT_STORE(((i) + 1) & 1, KRA, VRA);     \
        __syncthreads(); \
        if (KIND == 0) { const u32x4 fa_ = *(const LAS u32x4*)(dflag + ((i) & 1) * 8), fb_ = *(const LAS u32x4*)(dflag + ((i) & 1) * 8 + 4); \
            stop_ = (fa_.x & fa_.y & fa_.z & fa_.w & fb_.x & fb_.y & fb_.z & fb_.w) != 0u; } } while (0)
    ATT_LOAD(0, krA, vrA); ATT_STORE(0, krA, vrA); __syncthreads();
    LAS unsigned* dflag = (LAS unsigned*)(lds + 2 * BUFB); const int wid = tid >> 6; bool stop_ = false;
    for (int i = 0; i < nt; i += 2) { ATT_ITER(i, krA, vrA, krA, vrA); if (stop_) break; ATT_ITER(i + 1, krA, vrA, krA, vrA); if (stop_) break; }
    if (KIND == 0) __syncthreads();
#undef ATT_ITER
#undef ATT_LOAD
#undef ATT_STORE
#undef ATT_TILE_GEOM
    LAS unsigned char* stg = lds + 40960 + (tid >> 6) * 8704;
    float scale;
    if (KIND == 0) {
        float ss = 0.f;
#pragma unroll
        for (int d0 = 0; d0 < 4; ++d0)
#pragma unroll
            for (int r = 0; r < 16; ++r) ss += o[d0][r] * o[d0][r];
        ss = xhalf_sum(ss);
        scale = 1.f / sqrtf(ss * (1.f / HD) + RMS_EPS);
    } else {
        const float l = xhalf_sum(st1); scale = 1.f / l;
        if (hi == 0) lse_out[(size_t)tq * 8 + (ocol >> 7)] = st0 + __builtin_amdgcn_logf(l);
    }
#pragma unroll
    for (int d0 = 0; d0 < 4; ++d0)
#pragma unroll
        for (int i4 = 0; i4 < 4; ++i4) { f32x4 g = {1.f, 1.f, 1.f, 1.f}; if (KIND == 0) g = *(const f32x4*)(gain + ocol + 32 * d0 + 8 * i4 + 4 * hi);
            u32x2 w; w.x = pk2(o[d0][4 * i4] * scale * g[0], o[d0][4 * i4 + 1] * scale * g[1]); w.y = pk2(o[d0][4 * i4 + 2] * scale * g[2], o[d0][4 * i4 + 3] * scale * g[3]);
            *(LAS u32x2*)(stg + r32 * 272 + (32 * d0 + 8 * i4 + 4 * hi) * 2) = w; }
    asm volatile("s_waitcnt lgkmcnt(0)" ::: "memory");
#pragma unroll
    for (int it = 0; it < 8; ++it) { const int row = it * 4 + (lane >> 4), ch = lane & 15;
        const u32x4 v = *(const LAS u32x4*)(stg + row * 272 + ch * 16);
        const int tok = rb + (lw0 + row) * dil + res_w;
        *(u32x4*)(Out + (size_t)tok * out_pitch + ocol + ch * 8) = v; }
    asm volatile("s_waitcnt lgkmcnt(0)" ::: "memory");
}
}

__device__ __forceinline__ float gelu_tanh(float x) { const float t = x * (1.f + 0.044715f * x * x) * 2.3022081983f; return x / (1.f + __builtin_amdgcn_exp2f(-t)); }

#define XB_TMO      128
#define XB_XCNT(j)  (256  + 64 * (j))
#define XB_XSUB(j)  (1280 + 64 * (j))
#define XB_XGEN(j)  (2304 + 64 * (j))
#define XB_TOP      3328
#define XB_TOPGEN   3392
#define XCD_BAR_WORDS 3456
#define XB_SPIN_CAP (1u << 18)

__device__ __forceinline__ unsigned xb_ld(unsigned* p)              { return __hip_atomic_load(p, __ATOMIC_RELAXED, __HIP_MEMORY_SCOPE_AGENT); }
__device__ __forceinline__ unsigned xb_add(unsigned* p, unsigned v) { return __hip_atomic_fetch_add(p, v, __ATOMIC_RELAXED, __HIP_MEMORY_SCOPE_AGENT); }
__device__ __forceinline__ unsigned xb_xcc_id() { return (unsigned)__builtin_amdgcn_s_getreg((3 << 11) | 20) & 0xFu; }
#define XB_SPIN(cond, bar) do { unsigned _sp = 0; while (cond) { __builtin_amdgcn_s_sleep(1); \
    if ((++_sp & 255u) == 0u) { if (xb_ld(&(bar)[XB_TMO])) break; if (_sp > XB_SPIN_CAP) { atomicAdd(&(bar)[XB_TMO], 1u); break; } } } } while (0)

struct XcdBarrier {
    unsigned* bar; unsigned x;
    volatile LAS unsigned* st;
};

__device__ __forceinline__ XcdBarrier xcd_barrier_post(unsigned* bar, volatile LAS unsigned* st) {
    XcdBarrier b; b.bar = bar; b.x = xb_xcc_id(); b.st = st;
    if (threadIdx.x == 0) (void)xb_add(&bar[XB_XCNT(b.x)], 1u);
    return b;
}
__device__ __forceinline__ void xcd_barrier_complete(unsigned* bar, unsigned x, unsigned& nloc, unsigned& nx) {
    const unsigned G = gridDim.x * gridDim.y * gridDim.z;
    unsigned sum, cnt, mine, sp = 0u;
    for (;;) {
        sum = 0u; cnt = 0u; mine = 0u;
#pragma unroll
        for (unsigned j = 0; j < 16; ++j) { const unsigned c = xb_ld(&bar[XB_XCNT(j)]); sum += c; cnt += (c > 0u) ? 1u : 0u; mine = (j == x) ? c : mine; }
        if (sum == G) break;
        __builtin_amdgcn_s_sleep(1);
        if ((++sp & 255u) == 0u) { if (xb_ld(&bar[XB_TMO])) break; if (sp > XB_SPIN_CAP) { atomicAdd(&bar[XB_TMO], 1u); break; } }
    }
    nloc = mine > 0u ? mine : 1u; nx = cnt > 0u ? cnt : 1u;
}

__device__ __forceinline__ void xcd_barrier(const XcdBarrier& b) {
    asm volatile("s_waitcnt vmcnt(0)" ::: "memory");
    __syncthreads();
    if (threadIdx.x == 0) {
        unsigned* bar = b.bar;
        __builtin_amdgcn_s_waitcnt(0);
        unsigned nloc = b.st[0], nx = b.st[1];
        if (nloc == 0u) { xcd_barrier_complete(bar, b.x, nloc, nx); b.st[0] = nloc; b.st[1] = nx; }
        const unsigned old = xb_add(&bar[XB_XSUB(b.x)], 1u);
        const unsigned gen = old / nloc;
        if (old + 1u == (gen + 1u) * nloc) {
            __builtin_amdgcn_fence(__ATOMIC_RELEASE, "agent");
            asm volatile("s_waitcnt vmcnt(0)" ::: "memory");
            const unsigned og = xb_add(&bar[XB_TOP], 1u);
            const unsigned tg = og / nx;
            if (og + 1u == (tg + 1u) * nx) xb_add(&bar[XB_TOPGEN], 1u);
            else XB_SPIN(xb_ld(&bar[XB_TOPGEN]) == tg, bar);
            __builtin_amdgcn_fence(__ATOMIC_ACQUIRE, "agent");
            xb_add(&bar[XB_XGEN(b.x)], 1u);
            asm volatile("s_waitcnt vmcnt(0)" ::: "memory");
        } else {
            XB_SPIN(xb_ld(&bar[XB_XGEN(b.x)]) == gen, bar);
            __builtin_amdgcn_fence(__ATOMIC_ACQUIRE, "agent");
            asm volatile("s_waitcnt vmcnt(0)" ::: "memory");
        }
    }
    __syncthreads();
}

struct Args { const float* in[13]; float* out; unsigned char* ws; int ph_lo, ph_hi; };
constexpr int N_PHASES = 9;
#ifndef DUP_P1
#define DUP_P1 1
#endif
#ifndef DUP_P6
#define DUP_P6 1
#endif
#ifndef DUP_SB
#define DUP_SB 1
#endif
#ifndef DUP_DL
#define DUP_DL 1
#endif
#ifndef DUP_SB
#define DUP_SB 1
#endif
#ifndef DUP_DL
#define DUP_DL 1
#endif
#ifndef DUP_P3
#define DUP_P3 1
#endif
#ifndef DUP_P5
#define DUP_P5 1
#endif
#ifndef DUP_P8
#define DUP_P8 1
#endif
#ifndef DUP_P0
#define DUP_P0 1
#endif
#ifndef DUP_P2
#define DUP_P2 1
#endif

__global__ void __launch_bounds__(NTHREADS, 2) fwd_kernel(Args args) {
    extern __shared__ __attribute__((aligned(16))) unsigned char lds_raw[];
    LAS unsigned char* lds = (LAS unsigned char*)lds_raw;
    cg::grid_group grid = cg::this_grid();
    const int tid = threadIdx.x, lane = tid & 63, wave = __builtin_amdgcn_readfirstlane(tid >> 6);
    const int G = gridDim.x, bx = blockIdx.x;
    const int gw = bx * NWAVES + wave, NGW = G * NWAVES;
    const int lo = args.ph_lo, hi_ph = args.ph_hi;
    unsigned char* ws = args.ws;
    const float* x = args.in[0]; const float* g_pre_mix = args.in[1]; const float* g_post_mix = args.in[2]; const float* g_pre_ffn = args.in[3]; const float* g_post_ffn = args.in[4];
    const float* w_in = args.in[5]; const float* g_sb = args.in[6]; const float* g_dil = args.in[7]; const float* w_out = args.in[8]; const float* w_up = args.in[9];
    const float* conv_w = args.in[10]; const float* conv_b = args.in[11]; const float* w_down = args.in[12];
    float* out = args.out;
    bf16_t* Win_t = (bf16_t*)(ws + WS_WIN); bf16_t* Wout_t = (bf16_t*)(ws + WS_WOUT); bf16_t* Wup_t = (bf16_t*)(ws + WS_WUP); bf16_t* Wdown_t = (bf16_t*)(ws + WS_WDOWN);
    bf16_t* XN = (bf16_t*)(ws + WS_XN); bf16_t* QKV = (bf16_t*)(ws + WS_QKV); bf16_t* MIXED = (bf16_t*)(ws + WS_MIXED); bf16_t* MIXOUT = (bf16_t*)(ws + WS_MIXOUT);
    bf16_t* OB0 = (bf16_t*)(ws + WS_OB0); bf16_t* OB1 = (bf16_t*)(ws + WS_OB1); bf16_t* OB2 = (bf16_t*)(ws + WS_OB2); float* LSE = (float*)(ws + WS_LSE);
    float* HALO = (float*)(ws + WS_HALO); unsigned* FLAGS = (unsigned*)(ws + WS_FLAGS); bf16_t* Y = (bf16_t*)(ws + WS_Y); float* RSTD1 = (float*)(ws + WS_RSTD1); bf16_t* F = (bf16_t*)(ws + WS_XN); float* ROPE = (float*)(ws + WS_ROPE);
    volatile LAS unsigned* bar_st = (volatile LAS unsigned*)(lds + XCH_OFF + 8192);
    if (tid < 2) bar_st[tid] = 0u;
    __syncthreads();
    unsigned* BAR = (unsigned*)(ws + WS_BAR);
    XcdBarrier xbar = xcd_barrier_post(BAR, bar_st);
    if (args.ph_hi > 1000) grid.sync();
#define IN(k) (lo <= (k) && (k) < hi_ph)
#define SEAM(k) do { if (IN(k) && IN((k) + 1)) xcd_barrier(xbar); } while (0)

    for (int rep_ = 0; rep_ < DUP_P0; ++rep_) if (IN(0)) {
        LAS float* scr = (LAS float*)(lds + wave * 16384);
        constexpr int I_IN = (D / 64) * (NQKV / 32), I_OUT = (D / 64) * (D / 32), I_UP = (D / 64) * (NUP / 32), I_DN = (DFF / 64) * (D / 32);
        constexpr int NITEMS = I_IN + I_OUT + I_UP; (void)I_DN;
        for (int it = gw; it < NITEMS; it += NGW) {
            int r = it;
            if (r < I_IN) { p0_transpose_item<1>(w_in, D, NQKV, Win_t, scr, r, lane); continue; } r -= I_IN;
            if (r < I_OUT) { p0_transpose_item<0>(w_out, D, D, Wout_t, scr, r, lane); continue; } r -= I_OUT;
            p0_transpose_item<2>(w_up, D, NUP, Wup_t, scr, r, lane);
        }
        for (int e = bx * NTHREADS + tid; e < SEQ * 64; e += G * NTHREADS) { const int pos = e >> 6, i = e & 63;
            const float inv_freq = exp2f(-(float)i * (13.287712379549449f / 64.f));
            const float ang = (float)pos * inv_freq; float rev = ang * 0.15915494309189535f; rev = rev - floorf(rev);
            ROPE[2 * e] = __builtin_amdgcn_cosf(rev); ROPE[2 * e + 1] = __builtin_amdgcn_sinf(rev); }
        for (int m = gw; m < M; m += NGW) rms_row_to_bf16(x + (size_t)m * D, g_pre_mix, XN + (size_t)m * D, lane);
    }
    SEAM(0);
    if (IN(1)) {
        pg8::Gemm g{XN, Win_t, M, NQKV, D}; pg8::StaticOrder S; S.init(M, NQKV, G, bx);
        pg8::EpiQKV E{QKV, ROPE, C2};
        pg8::gemm_phase<pg8::EpiQKV, pg8::StaticOrder, true, true>(lds, g, S, E);
    }
#if DUP_P1 > 1
    if (IN(1)) {
        pg8::Gemm g{XN, Win_t, M, NQKV, D}; pg8::StaticOrder S; S.init(M, NQKV, G, bx);
        pg8::EpiQKV E{QKV, ROPE, C2};
        pg8::gemm_phase<pg8::EpiQKV, pg8::StaticOrder, true, true>(lds, g, S, E);
    }
#endif
    SEAM(1);
    if (IN(2)) {
        const int vcu = (G % 8 == 0) ? (bx % 8) * (G / 8) + bx / 8 : bx;
        for (int p = vcu; p < 256; p += G) { const int bh = p >> 2, s = p & 3, b = bh >> 3, h = bh & 7;
            for (int k = 0; k < 2; ++k) { const int qb = k ? 7 - s : s;
                att::attn_unit<0>(lds, QKV, b * SEQ, 1, 0, 1 << 20, 4 * qb + 4, 256 * qb + 192, -64, 0, 256 * qb + 32 * wave, h * HD, 1024 + h * HD, 2048 + h * HD, MIXED, D, h * HD, g_sb, nullptr); } }
        for (int p = vcu; p < 256; p += G) { const int bh = p >> 2, b = bh >> 3, h = bh & 7;
            for (int k = 0; k < 6; ++k) { const int u = (k >> 1) * 8 + (p & 3) * 2 + (k & 1); const int qc = 3072 + h * HD, kc = 4096 + h * HD, vc = 5120 + h * HD;
                if (u < 8) { const int np = u; const int ks0 = np == 0 ? 0 : 256 * np - 128; const int nt = np == 0 ? 4 : 6;
                    att::attn_unit<1>(lds, QKV, b * SEQ, 1, 0, 1 << 20, nt, ks0, 64, 0, 256 * np + 32 * wave, qc, kc, vc, OB0, 1024, h * HD, nullptr, LSE); }
                else if (u < 16) { const int res = (u - 8) >> 1, np = (u - 8) & 1; const int ks0 = np == 0 ? 0 : 128; const int nt = np == 0 ? 4 : 6;
                    att::attn_unit<1>(lds, QKV, b * SEQ, 4, res, 1 << 20, nt, ks0, 64, res, 256 * np + 32 * wave, qc, kc, vc, OB1, 1024, h * HD, nullptr, LSE + (size_t)M * 8); }
                else { const int rp = u - 16;
                    att::attn_unit<1>(lds, QKV, b * SEQ, 16, 2 * rp, 2, 4, 0, 64, 2 * rp + (wave >> 2), 32 * (wave & 3), qc, kc, vc, OB2, 1024, h * HD, nullptr, LSE + (size_t)2 * M * 8); }
            } }
    }
    SEAM(2);
    if (IN(3)) {
        for (int m = gw; m < M; m += NGW) { const int hh = lane >> 3;
            const float l0 = LSE[(size_t)m * 8 + hh], l1 = LSE[(size_t)(M + m) * 8 + hh], l2 = LSE[(size_t)(2 * M + m) * 8 + hh];
            const float mx = fmaxf(l0, fmaxf(l1, l2)); float w0 = __builtin_amdgcn_exp2f(l0 - mx), w1 = __builtin_amdgcn_exp2f(l1 - mx), w2 = __builtin_amdgcn_exp2f(l2 - mx);
            const float wi = 1.f / (w0 + w1 + w2); w0 *= wi; w1 *= wi; w2 *= wi;
            float v[16]; float ss = 0.f;
#pragma unroll
            for (int c = 0; c < 2; ++c) { const size_t off = (size_t)m * 1024 + lane * 16 + c * 8;
                const u32x4 a0 = ldntu4((const u32x4*)(OB0 + off)), a1 = ldntu4((const u32x4*)(OB1 + off)), a2 = ldntu4((const u32x4*)(OB2 + off));
#pragma unroll
                for (int j = 0; j < 4; ++j) { v[c * 8 + 2 * j] = w0 * bf_lo(a0[j]) + w1 * bf_lo(a1[j]) + w2 * bf_lo(a2[j]); v[c * 8 + 2 * j + 1] = w0 * bf_hi(a0[j]) + w1 * bf_hi(a1[j]) + w2 * bf_hi(a2[j]); } }
#pragma unroll
            for (int j = 0; j < 16; ++j) ss += v[j] * v[j];
            ss += __shfl_xor(ss, 1); ss += __shfl_xor(ss, 2); ss += __shfl_xor(ss, 4);
            const float rstd = 1.f / sqrtf(ss * (1.f / HD) + RMS_EPS);
#pragma unroll
            for (int c = 0; c < 2; ++c) { const f32x4 ga = *(const f32x4*)(g_dil + lane * 16 + c * 8), gb = *(const f32x4*)(g_dil + lane * 16 + c * 8 + 4);
                u32x4 w; w.x = pk2(v[c * 8] * rstd * ga[0], v[c * 8 + 1] * rstd * ga[1]); w.y = pk2(v[c * 8 + 2] * rstd * ga[2], v[c * 8 + 3] * rstd * ga[3]);
                w.z = pk2(v[c * 8 + 4] * rstd * gb[0], v[c * 8 + 5] * rstd * gb[1]); w.w = pk2(v[c * 8 + 6] * rstd * gb[2], v[c * 8 + 7] * rstd * gb[3]);
                *(u32x4*)(MIXED + (size_t)m * D + 1024 + lane * 16 + c * 8) = w; } }
    }
    SEAM(3);
    if (IN(4)) {
        pg8::Gemm g{MIXED, Wout_t, M, D, D}; pg8::StaticOrder S; S.init(M, D, G, bx);
        pg8::EpiBf16 E{MIXOUT, D};
        pg8::gemm_phase<pg8::EpiBf16, pg8::StaticOrder, true, true>(lds, g, S, E);
    }
    SEAM(4);
    if (IN(5)) {
        for (int m = gw; m < M; m += NGW) {
            const u32x2* mr = (const u32x2*)(MIXOUT + (size_t)m * D) + lane; const f32x4* xr = (const f32x4*)(x + (size_t)m * D) + lane;
            f32x4 v[8]; float s = 0.f;
#pragma unroll
            for (int j = 0; j < 8; ++j) { const u32x2 w = ldntu2(mr + 64 * j); v[j] = (f32x4){bf_lo(w.x), bf_hi(w.x), bf_lo(w.y), bf_hi(w.y)}; s += (v[j][0] * v[j][0] + v[j][1] * v[j][1]) + (v[j][2] * v[j][2] + v[j][3] * v[j][3]); }
            const float rstd = 1.f / sqrtf(wave_sum(s) * (1.f / D) + RMS_EPS);
            float s2 = 0.f; if (lane == 0) RSTD1[m] = rstd;
#pragma unroll
            for (int j = 0; j < 8; ++j) { const f32x4 g = ((const f32x4*)g_post_mix)[lane + 64 * j]; const f32x4 xv = ldnt4(xr + 64 * j);
                v[j] = xv + v[j] * rstd * g; s2 += (v[j][0] * v[j][0] + v[j][1] * v[j][1]) + (v[j][2] * v[j][2] + v[j][3] * v[j][3]); }
            const float rstd2 = 1.f / sqrtf(wave_sum(s2) * (1.f / D) + RMS_EPS);
            u32x2* o8 = (u32x2*)(XN + (size_t)m * D) + lane;
#pragma unroll
            for (int j = 0; j < 8; ++j) { const f32x4 g = ((const f32x4*)g_pre_ffn)[lane + 64 * j]; u32x2 w; w.x = pk2(v[j][0] * rstd2 * g[0], v[j][1] * rstd2 * g[1]); w.y = pk2(v[j][2] * rstd2 * g[2], v[j][3] * rstd2 * g[3]); o8[64 * j] = w; }
        }
    }
    SEAM(5);
    if (IN(6)) {
        pg8::Gemm g{XN, Wup_t, M, NUP, D}; pg8::StaticOrder S; S.init(M, NUP, G, bx);
        pg8::EpiConv E{Y, conv_w, conv_b, HALO, FLAGS, lds + XCH_OFF, NUP / 256};
        pg8::gemm_phase<pg8::EpiConv, pg8::StaticOrder, true, true>(lds, g, S, E);
        { const int nun = (M / 256) * (NUP / 256); const int rem = nun % G; const int first = rem, nw = (G - first) * NWAVES;
          if (bx >= first) { LAS float* scr = (LAS float*)(lds + wave * 16384); constexpr int I_DN2 = (DFF / 64) * (D / 32);
              for (int it = (bx - first) * NWAVES + wave; it < I_DN2; it += nw) p0_transpose_item<0>(w_down, DFF, D, Wdown_t, scr, it, lane); } }
    }
#if DUP_P6 > 1
    if (IN(6)) {
        pg8::Gemm g{XN, Wup_t, M, NUP, D}; pg8::StaticOrder S; S.init(M, NUP, G, bx);
        pg8::EpiConv E{Y, conv_w, conv_b, HALO, FLAGS, lds + XCH_OFF, NUP / 256};
        pg8::gemm_phase<pg8::EpiConv, pg8::StaticOrder, true, true>(lds, g, S, E);
    }
#endif
    SEAM(6);
    if (IN(7)) {
        pg8::Gemm g{Y, Wdown_t, M, D, DFF}; pg8::StaticOrder S; S.init(M, D, G, bx);
        pg8::EpiBf16 E{F, D};
        pg8::gemm_phase<pg8::EpiBf16, pg8::StaticOrder, true, true>(lds, g, S, E);
    }
    SEAM(7);
    if (IN(8)) {
        for (int m = gw; m < M; m += NGW) {
            const u32x2* fr_ = (const u32x2*)(F + (size_t)m * D) + lane; f32x4* orow = (f32x4*)(out + (size_t)m * D) + lane;
            f32x4 v[8]; float s = 0.f;
#pragma unroll
            for (int j = 0; j < 8; ++j) { const u32x2 w = ldntu2(fr_ + 64 * j); v[j] = (f32x4){bf_lo(w.x), bf_hi(w.x), bf_lo(w.y), bf_hi(w.y)}; s += (v[j][0] * v[j][0] + v[j][1] * v[j][1]) + (v[j][2] * v[j][2] + v[j][3] * v[j][3]); }
            const float rstd = 1.f / sqrtf(wave_sum(s) * (1.f / D) + RMS_EPS);
            const float rstd1 = RSTD1[m]; const u32x2* mr = (const u32x2*)(MIXOUT + (size_t)m * D) + lane; const f32x4* xr = (const f32x4*)(x + (size_t)m * D) + lane;
#pragma unroll
            for (int j = 0; j < 8; ++j) { const f32x4 g = ((const f32x4*)g_post_ffn)[lane + 64 * j]; const f32x4 g1 = ((const f32x4*)g_post_mix)[lane + 64 * j];
                const u32x2 w = ldntu2(mr + 64 * j); const f32x4 mo = (f32x4){bf_lo(w.x), bf_hi(w.x), bf_lo(w.y), bf_hi(w.y)};
                const f32x4 x1 = ldnt4(xr + 64 * j) + mo * rstd1 * g1;
                stnt4(orow + 64 * j, x1 + v[j] * rstd * g); }
        }
    }
#undef IN
#undef SEAM
}

extern "C" void kernel_launch(void* const* d_in, const int* in_sizes, int n_in, void* d_out, int out_size, void* d_ws, size_t ws_size, hipStream_t stream) {
    static int grid = 0;
    if (grid == 0) {
        if (n_in != 13 || in_sizes[0] != M * D || out_size != M * D || ws_size < WS_END) { fprintf(stderr, "kernel_launch: unexpected shapes (n_in %d, in0 %d, out %d, ws %zu)\n", n_in, n_in > 0 ? in_sizes[0] : -1, out_size, ws_size); grid = -1; return; }
        int dev = 0, cus = 0, per_cu = 0;
        hipGetDevice(&dev); hipDeviceGetAttribute(&cus, hipDeviceAttributeMultiprocessorCount, dev);
        if (hipFuncSetAttribute((const void*)fwd_kernel, hipFuncAttributeMaxDynamicSharedMemorySize, LDS_BYTES) != hipSuccess) { fprintf(stderr, "kernel_launch: hipFuncSetAttribute failed\n"); grid = -1; return; }
        if (hipOccupancyMaxActiveBlocksPerMultiprocessor(&per_cu, (const void*)fwd_kernel, NTHREADS, LDS_BYTES) != hipSuccess || per_cu < 1) { fprintf(stderr, "kernel_launch: occupancy query says %d\n", per_cu); per_cu = 1; }
        (void)hipGetLastError();
        grid = cus * (per_cu > 1 ? 1 : per_cu);
        if (grid <= 0) grid = 256;
    }
    if (grid < 0) return;
    if (hipMemsetAsync(d_ws, 0, 131072, stream) != hipSuccess) { fprintf(stderr, "kernel_launch: memset failed\n"); return; }
    Args a{};
    for (int i = 0; i < 13; ++i) a.in[i] = (const float*)d_in[i];
    a.out = (float*)d_out; a.ws = (unsigned char*)d_ws;
#if ONE_LAUNCH
    a.ph_lo = 0; a.ph_hi = N_PHASES;
    void* kargs[] = {&a};
    hipError_t e = hipLaunchCooperativeKernel((const void*)fwd_kernel, dim3(grid), dim3(NTHREADS), kargs, LDS_BYTES, stream);
    if (e != hipSuccess) fprintf(stderr, "kernel_launch: cooperative launch failed: %s (grid %d)\n", hipGetErrorString(e), grid);
#else
    for (int ph = 0; ph < N_PHASES; ++ph) { a.ph_lo = ph; a.ph_hi = ph + 1; hipLaunchKernelGGL(fwd_kernel, dim3(grid), dim3(NTHREADS), LDS_BYTES, stream, a); }
#endif
}
```
